# Optimizing an MI355X kernel written in HIP

```python
import jax, jax.numpy as jnp
from jax import lax
import numpy as np

D_MODEL = 1024
BATCH = 8
SEQ = 2048
DEPTH = 1
DEC_BATCH = 128
DEC_SEQ = 4
PAST_LEN = 16384
PAGE_SIZE = 128

H_A = 4
DK_A = 128
DV_A = 128
H_B = 4
DK_B = 128
DV_B = 128
CONV_W = 4
CHUNK = 64
PLE_DIM = 256
N_KEYS = 128
N_EXPERTS = N_KEYS * N_KEYS
PEER_HEADS = 8
PEER_QDIM = 256
PEER_HALF = PEER_QDIM // 2
PEER_TOPK = 16
PEER_BLOCK = 256
EPS = 1e-6

W_A = H_A * DK_A
W_AV = H_A * DV_A
W_BK = H_B * DK_B
W_BV = H_B * DV_B
CONV_CH = 2 * W_BK + W_BV
SPLIT_SIZES = (W_A, W_A, W_AV, W_AV, W_BK, W_BK, W_BV, W_BV, H_B, H_B, D_MODEL, D_MODEL)
IN_COLS = int(sum(SPLIT_SIZES))
SPLIT_POINTS = tuple(int(v) for v in np.cumsum(SPLIT_SIZES)[:-1])
F32 = jnp.float32

kernel_name = 'hgrn2_gdn_peer_hybrid_step'


def rmsnorm(x, g):
    xf = x.astype(F32)
    y = xf * lax.rsqrt(jnp.mean(xf * xf, axis=-1, keepdims=True) + EPS)
    return (y * g.astype(F32)).astype(x.dtype)


def head_rmsnorm(o, g):
    return o * lax.rsqrt(jnp.mean(o * o, axis=-1, keepdims=True) + EPS) * g.astype(F32)


def l2norm(x):
    return x * lax.rsqrt(jnp.sum(x * x, axis=-1, keepdims=True) + EPS)


def _to_chunks(a, c, n):
    t = a.shape[1]
    pad = [(0, 0)] * a.ndim
    pad[1] = (0, n * c - t)
    a = jnp.pad(a, pad)
    a = a.reshape(a.shape[0], n, c, *a.shape[2:])
    return jnp.moveaxis(a, 1, 0)


def _from_chunks(a, t):
    a = jnp.moveaxis(a, 0, 1)
    a = a.reshape(a.shape[0], -1, *a.shape[3:])
    return a[:, :t]


def hgrn2_recurrence(q, k, v, logf, s0):
    t = q.shape[1]
    c = min(CHUNK, t)
    n = -(-t // c)
    mask = jnp.tril(jnp.ones((c, c), bool))[None, :, :, None, None]

    def step(s, inp):
        qc, kc, vc, gc = inp
        b = jnp.cumsum(gc, axis=1)
        diff = b[:, :, None] - b[:, None, :]
        dec = jnp.where(mask, jnp.exp(jnp.minimum(diff, 0.0)), 0.0)
        att = jnp.einsum('bthd,bshd,btshd->bhts', qc, kc, dec)
        o = (jnp.einsum('bhts,bshv->bthv', att, vc)
             + jnp.einsum('bthd,bhdv->bthv', qc * jnp.exp(b), s))
        bl = b[:, -1]
        s = (jnp.exp(bl)[..., None] * s
             + jnp.einsum('bshd,bshv->bhdv', kc * jnp.exp(bl[:, None] - b), vc))
        return s, o

    xs = tuple(_to_chunks(a, c, n) for a in (q, k, v, logf))
    s, o = lax.scan(step, s0, xs)
    return _from_chunks(o, t), s


def gated_delta_recurrence(q, k, v, g, beta, s0):
    t = q.shape[1]
    c = min(CHUNK, t)
    n = -(-t // c)
    incl = jnp.tril(jnp.ones((c, c), bool))
    strict = jnp.tril(jnp.ones((c, c), bool), -1)
    eye = jnp.eye(c, dtype=F32)

    def step(s, inp):
        qc, kc, vc, gc, bc = inp
        gcum = jnp.cumsum(gc, axis=1).transpose(0, 2, 1)
        diff = gcum[..., :, None] - gcum[..., None, :]
        gam = jnp.where(incl, jnp.exp(jnp.minimum(diff, 0.0)), 0.0)
        bt = bc.transpose(0, 2, 1)
        kk = jnp.einsum('bthd,bshd->bhts', kc, kc)
        lmat = jnp.where(strict, bt[..., :, None] * gam * kk, 0.0)
        eg = jnp.exp(gcum)
        ks = jnp.einsum('bthd,bhdv->bhtv', kc, s)
        rhs = bt[..., None] * (vc.transpose(0, 2, 1, 3) - eg[..., None] * ks)
        u = lax.linalg.triangular_solve(eye + lmat, rhs, left_side=True, lower=True,
                                        unit_diagonal=True)
        qk = jnp.einsum('bthd,bshd->bhts', qc, kc) * gam
        o = (jnp.einsum('bhts,bhsv->bhtv', qk, u)
             + eg[..., None] * jnp.einsum('bthd,bhdv->bhtv', qc, s))
        gl = gcum[..., -1]
        kdec = kc * jnp.exp(gl[..., None] - gcum).transpose(0, 2, 1)[..., None]
        s = jnp.exp(gl)[..., None, None] * s + jnp.einsum('bshd,bhsv->bhdv', kdec, u)
        return s, o.transpose(0, 2, 1, 3)

    xs = tuple(_to_chunks(a, c, n) for a in (q, k, v, g, beta))
    s, o = lax.scan(step, s0, xs)
    return _from_chunks(o, t), s


def peer_ffn(h, peer_wq, peer_keys, expert_u, expert_v):
    bsz, t, d = h.shape
    n_tok = bsz * t
    blk = min(PEER_BLOCK, n_tok)
    n_blk = -(-n_tok // blk)
    hf = jnp.pad(h.reshape(n_tok, d), ((0, n_blk * blk - n_tok), (0, 0))).reshape(n_blk, blk, d)

    def block(hb):
        q = (hb @ peer_wq).astype(F32).reshape(blk, PEER_HEADS, 2, PEER_HALF)
        sc = jnp.einsum('nhcd,hckd->nhck', q, peer_keys.astype(F32))
        s1, i1 = lax.top_k(sc[:, :, 0], PEER_TOPK)
        s2, i2 = lax.top_k(sc[:, :, 1], PEER_TOPK)
        cand = (s1[..., :, None] + s2[..., None, :]).reshape(blk, PEER_HEADS, PEER_TOPK * PEER_TOPK)
        s_top, ci = lax.top_k(cand, PEER_TOPK)
        ia = jnp.take_along_axis(i1, ci // PEER_TOPK, axis=-1)
        ib = jnp.take_along_axis(i2, ci % PEER_TOPK, axis=-1)
        idx = ia * N_KEYS + ib
        gate = jax.nn.softmax(s_top, axis=-1)
        u = expert_u[idx]
        act = jax.nn.gelu(jnp.einsum('nd,nhkd->nhk', hb, u).astype(F32))
        wgt = (gate * act).astype(hb.dtype)
        return jnp.einsum('nhk,nhkd->nd', wgt, expert_v[idx])

    out = lax.map(block, hf)
    return out.reshape(n_blk * blk, d)[:n_tok].reshape(bsz, t, d)


def decoder_layer(x, p, s_a, s_b, conv_buf, lb, g_mix, w_in, conv_w, a_log, dt_bias,
                  g_norm_a, g_norm_b, w_br_a, w_br_b, w_out, g_ffn, peer_wq, peer_keys,
                  expert_u, expert_v, g_ple, w_ple, w_ple_gate):
    bsz, t, _ = x.shape
    h = rmsnorm(x, g_mix)
    proj = h @ w_in
    (qa, fa, ia, oga, qb, kb, vb, zb, bb, ab, gate_a, gate_b) = jnp.split(proj, SPLIT_POINTS, axis=-1)

    lbh = lb.reshape(H_A, DK_A)
    q_a = jax.nn.silu(qa.astype(F32)).reshape(bsz, t, H_A, DK_A)
    f_a = lbh + (1.0 - lbh) * jax.nn.sigmoid(fa.astype(F32).reshape(bsz, t, H_A, DK_A))
    k_a = 1.0 - f_a
    v_a = ia.astype(F32).reshape(bsz, t, H_A, DV_A)
    o_a, s_a_new = hgrn2_recurrence(q_a, k_a, v_a, jnp.log(f_a), s_a.astype(F32))
    o_a = head_rmsnorm(o_a, g_norm_a) * jax.nn.silu(oga.astype(F32)).reshape(bsz, t, H_A, DV_A)
    y_a = o_a.reshape(bsz, t, W_AV).astype(x.dtype) @ w_br_a

    raw = jnp.concatenate([qb, kb, vb], axis=-1)
    xcat = jnp.concatenate([conv_buf.astype(raw.dtype), raw], axis=1)
    conv = xcat[:, 0:t] * conv_w[0]
    for j in range(1, CONV_W):
        conv = conv + xcat[:, j:j + t] * conv_w[j]
    conv = jax.nn.silu(conv.astype(F32))
    new_buf = xcat[:, t:]
    qc, kc, vc = jnp.split(conv, (W_BK, 2 * W_BK), axis=-1)
    q_b = l2norm(qc.reshape(bsz, t, H_B, DK_B)) * (DK_B ** -0.5)
    k_b = l2norm(kc.reshape(bsz, t, H_B, DK_B))
    v_b = vc.reshape(bsz, t, H_B, DV_B)
    g_b = -jnp.exp(a_log.astype(F32)) * jax.nn.softplus(ab.astype(F32) + dt_bias.astype(F32))
    beta_b = jax.nn.sigmoid(bb.astype(F32))
    o_b, s_b_new = gated_delta_recurrence(q_b, k_b, v_b, g_b, beta_b, s_b.astype(F32))
    o_b = head_rmsnorm(o_b, g_norm_b) * jax.nn.silu(zb.astype(F32)).reshape(bsz, t, H_B, DV_B)
    y_b = o_b.reshape(bsz, t, W_BV).astype(x.dtype) @ w_br_b

    merged = jax.nn.sigmoid(gate_a) * y_a + jax.nn.sigmoid(gate_b) * y_b
    x = x + merged @ w_out

    x = x + peer_ffn(rmsnorm(x, g_ffn), peer_wq, peer_keys, expert_u, expert_v)

    ple_gate = jax.nn.sigmoid(rmsnorm(x, g_ple) @ w_ple_gate)
    x = x + (p.astype(x.dtype) @ w_ple) * ple_gate
    return x, s_a_new, s_b_new, new_buf


def setup_inputs(seed: int = 0) -> dict:
    key = jax.random.key(seed)
    ks = list(jax.random.split(key, 40))

    def nrm(i, shape, scale):
        return jax.random.normal(ks[i], shape, F32) * scale

    dt = jnp.exp(jax.random.uniform(ks[30], (DEPTH, H_B), F32, np.log(1e-3), np.log(1e-1)))
    return {
        'x_prompt': nrm(0, (BATCH, SEQ, D_MODEL), 1.0),
        'x_sample': nrm(1, (DEC_BATCH, DEC_SEQ, D_MODEL), 1.0),
        'state_hgrn': nrm(2, (DEPTH, DEC_BATCH, H_A, DK_A, DV_A), 0.5),
        'state_delta': nrm(3, (DEPTH, DEC_BATCH, H_B, DK_B, DV_B), 0.2),
        'state_conv': nrm(4, (DEPTH, DEC_BATCH, CONV_W - 1, CONV_CH), 1.0),
        'p_prompt': nrm(5, (DEPTH, BATCH, SEQ, PLE_DIM), 1.0),
        'p_sample': nrm(6, (DEPTH, DEC_BATCH, DEC_SEQ, PLE_DIM), 1.0),
        'lb_param': nrm(7, (DEPTH + 1, W_A), 1.0),
        'g_mix': 1.0 + nrm(8, (DEPTH, D_MODEL), 0.01),
        'w_in': nrm(9, (DEPTH, D_MODEL, IN_COLS), D_MODEL ** -0.5),
        'conv_w': nrm(10, (DEPTH, CONV_W, CONV_CH), CONV_W ** -0.5),
        'a_log': jnp.log(jax.random.uniform(ks[11], (DEPTH, H_B), F32, 1.0, 16.0)),
        'dt_bias': jnp.log(jnp.expm1(dt)),
        'g_norm_a': 1.0 + nrm(12, (DEPTH, DV_A), 0.01),
        'g_norm_b': 1.0 + nrm(13, (DEPTH, DV_B), 0.01),
        'w_br_a': nrm(14, (DEPTH, W_AV, D_MODEL), W_AV ** -0.5),
        'w_br_b': nrm(15, (DEPTH, W_BV, D_MODEL), W_BV ** -0.5),
        'w_out': nrm(16, (DEPTH, D_MODEL, D_MODEL), D_MODEL ** -0.5),
        'g_ffn': 1.0 + nrm(17, (DEPTH, D_MODEL), 0.01),
        'peer_wq': nrm(18, (DEPTH, D_MODEL, PEER_HEADS * PEER_QDIM), D_MODEL ** -0.5),
        'peer_keys': nrm(19, (DEPTH, PEER_HEADS, 2, N_KEYS, PEER_HALF), PEER_HALF ** -0.5),
        'expert_u': nrm(20, (DEPTH, N_EXPERTS, D_MODEL), D_MODEL ** -0.5),
        'expert_v': nrm(21, (DEPTH, N_EXPERTS, D_MODEL), (PEER_HEADS * PEER_TOPK) ** -0.5),
        'g_ple': 1.0 + nrm(22, (DEPTH, D_MODEL), 0.01),
        'w_ple': nrm(23, (DEPTH, PLE_DIM, D_MODEL), 0.5 * PLE_DIM ** -0.5),
        'w_ple_gate': nrm(24, (DEPTH, D_MODEL, D_MODEL), D_MODEL ** -0.5),
        'g_final': 1.0 + nrm(25, (D_MODEL,), 0.01),
    }


def reference(x_prompt, x_sample, state_hgrn, state_delta, state_conv, p_prompt, p_sample,
              lb_param, g_mix, w_in, conv_w, a_log, dt_bias, g_norm_a, g_norm_b, w_br_a, w_br_b,
              w_out, g_ffn, peer_wq, peer_keys, expert_u, expert_v, g_ple, w_ple, w_ple_gate,
              g_final):
    lb_all = jnp.cumsum(jax.nn.softmax(lb_param.astype(F32), axis=0), axis=0)
    xp, xs = x_prompt, x_sample
    hp, dp, cp, hs, ds, cs = [], [], [], [], [], []
    for i in range(DEPTH):
        lw = (g_mix[i], w_in[i], conv_w[i], a_log[i], dt_bias[i], g_norm_a[i], g_norm_b[i],
              w_br_a[i], w_br_b[i], w_out[i], g_ffn[i], peer_wq[i], peer_keys[i], expert_u[i],
              expert_v[i], g_ple[i], w_ple[i], w_ple_gate[i])
        za = jnp.zeros((BATCH, H_A, DK_A, DV_A), F32)
        zb = jnp.zeros((BATCH, H_B, DK_B, DV_B), F32)
        zc = jnp.zeros((BATCH, CONV_W - 1, CONV_CH), xp.dtype)
        xp, sa, sb, sc = decoder_layer(xp, p_prompt[i], za, zb, zc, lb_all[i], *lw)
        hp.append(sa.astype(state_hgrn.dtype))
        dp.append(sb.astype(state_delta.dtype))
        cp.append(sc.astype(state_conv.dtype))
        xs, sa2, sb2, sc2 = decoder_layer(xs, p_sample[i], state_hgrn[i], state_delta[i],
                                          state_conv[i], lb_all[i], *lw)
        hs.append(sa2.astype(state_hgrn.dtype))
        ds.append(sb2.astype(state_delta.dtype))
        cs.append(sc2.astype(state_conv.dtype))
    y_prompt = rmsnorm(xp, g_final)
    y_sample = rmsnorm(xs, g_final)
    return (y_prompt, y_sample, jnp.stack(hp), jnp.stack(dp), jnp.stack(cp),
            jnp.stack(hs), jnp.stack(ds), jnp.stack(cs))
```

```cpp
#include <hip/hip_runtime.h>
#include <hip/hip_cooperative_groups.h>
#include <stdint.h>
#include <stdio.h>
namespace cg = cooperative_groups;

typedef unsigned short u16;
typedef __attribute__((ext_vector_type(8))) short bf16x8;
typedef __attribute__((ext_vector_type(16))) float f32x16;

#define NTP 16384
#define NTS 512
#define NT 16896
#define EPSF 1e-6f
#define NINF (-3.0e38f)

constexpr size_t OFF_WT_IN  = 0;
constexpr size_t OFF_WT_BRA = OFF_WT_IN + 12582912;
constexpr size_t OFF_WT_BRB = OFF_WT_BRA + 1048576;
constexpr size_t OFF_WT_OUT = OFF_WT_BRB + 1048576;
constexpr size_t OFF_WT_Q   = OFF_WT_OUT + 2097152;
constexpr size_t OFF_WT_PG  = OFF_WT_Q + 4194304;
constexpr size_t OFF_WT_PLE = OFF_WT_PG + 2097152;
constexpr size_t OFF_KEYS   = OFF_WT_PLE + 524288;
constexpr size_t OFF_H      = OFF_KEYS + 524288;
constexpr size_t OFF_BETA   = OFF_H + 34603008;
constexpr size_t OFF_GLOG   = OFF_BETA + 270336;
constexpr size_t OFF_DVEC   = OFF_GLOG + 270336;
constexpr size_t OFF_SSQO   = OFF_DVEC + 1048576;
constexpr size_t OFF_SSQ1   = OFF_SSQO + 2162688;
constexpr size_t OFF_SSQ3   = OFF_SSQ1 + 67584;
constexpr size_t OFF_R3     = OFF_SSQ3 + 67584;
constexpr size_t OFF_LOGF   = OFF_R3;
constexpr size_t OFF_VA     = OFF_R3 + 34603008;
constexpr size_t OFF_MRG    = OFF_R3;
constexpr size_t OFF_H2     = OFF_R3;
constexpr size_t OFF_R4     = OFF_R3 + 51904512;
constexpr size_t OFF_OGA    = OFF_R4;
constexpr size_t OFF_ZB     = OFF_R4 + 17301504;
constexpr size_t OFF_TOPS   = OFF_R4;
constexpr size_t OFF_TOPI   = OFF_R4 + 17301504;
constexpr size_t OFF_R5     = OFF_R4 + 34603008;
constexpr size_t OFF_O      = OFF_R5;
constexpr size_t OFF_H3     = OFF_R5;
constexpr size_t OFF_X1B    = OFF_R5;
constexpr size_t OFF_R6     = OFF_R5 + 34603008;
constexpr size_t OFF_QB     = OFF_R6;
constexpr size_t OFF_KT     = OFF_R6 + 33554432;
constexpr size_t OFF_VT     = OFF_R6 + 67108864;
constexpr size_t OFF_PN     = OFF_R6 + 100663296;
constexpr size_t OFF_EU     = OFF_R6;
constexpr size_t OFF_EV     = OFF_R6 + 16777216;
constexpr size_t OFF_BAR    = OFF_R6 + 134217728;
constexpr size_t OFF_MRG2   = OFF_BAR + 16384;
#define P4A_MAX_LEFT 64
constexpr size_t WS_TOTAL   = OFF_MRG2 + 64 * 32768;
static_assert(WS_TOTAL <= 330000000, "ws too big");

constexpr size_t OUT_Y   = 0;
constexpr size_t OUT_HP  = 17301504;
constexpr size_t OUT_DP  = 17825792;
constexpr size_t OUT_CP  = 18350080;
constexpr size_t OUT_HS  = 18386944;
constexpr size_t OUT_DS  = 26775552;
constexpr size_t OUT_CS  = 35164160;
constexpr size_t OUTB_RAW = 0;
constexpr size_t OUTB_QA  = 51904512;

struct Params {
  const float *x_prompt, *x_sample, *state_hgrn, *state_delta, *state_conv, *p_prompt, *p_sample,
      *lb_param, *g_mix, *w_in, *conv_w, *a_log, *dt_bias, *g_norm_a, *g_norm_b, *w_br_a, *w_br_b,
      *w_out, *g_ffn, *peer_wq, *peer_keys, *expert_u, *expert_v, *g_ple, *w_ple, *w_ple_gate, *g_final;
  float* out;
  char* ws;
};

#define SMEM_BYTES 145408
#ifndef PROBE
#define PROBE 0
#endif

typedef float f32x2_t __attribute__((ext_vector_type(2)));
typedef __bf16 bf16x2_t __attribute__((ext_vector_type(2)));
__device__ __forceinline__ unsigned pack2(float a, float b) {
  f32x2_t f = {a, b};
  bf16x2_t h = __builtin_convertvector(f, bf16x2_t);
  return __builtin_bit_cast(unsigned, h);
}
__device__ __forceinline__ u16 f2bf(float f) { return (u16)(pack2(f, f) & 0xffffu); }
__device__ __forceinline__ float bf2f(u16 h) { return __uint_as_float(((unsigned)h) << 16); }
__device__ __forceinline__ float bflo(unsigned u) { return __uint_as_float(u << 16); }
__device__ __forceinline__ float bfhi(unsigned u) { return __uint_as_float(u & 0xffff0000u); }
typedef float f32x4n __attribute__((ext_vector_type(4)));
__device__ __forceinline__ float4 nt_load4(const float* p) { f32x4n v = __builtin_nontemporal_load((const f32x4n*)p); return make_float4(v.x, v.y, v.z, v.w); }
__device__ __forceinline__ void nt_store4(float* p, float a, float b, float c, float d) { f32x4n v = {a, b, c, d}; __builtin_nontemporal_store(v, (f32x4n*)p); }
#define DPP_F(v, ctrl) __int_as_float(__builtin_amdgcn_update_dpp(0, __float_as_int(v), (ctrl), 0xF, 0xF, true))
__device__ __forceinline__ float dpp_row_sum16(float v) {
  v += __int_as_float(__builtin_amdgcn_update_dpp(0, __float_as_int(v), 0xB1, 0xF, 0xF, true));
  v += __int_as_float(__builtin_amdgcn_update_dpp(0, __float_as_int(v), 0x4E, 0xF, 0xF, true));
  v += __int_as_float(__builtin_amdgcn_update_dpp(0, __float_as_int(v), 0x141, 0xF, 0xF, true));
  v += __int_as_float(__builtin_amdgcn_update_dpp(0, __float_as_int(v), 0x140, 0xF, 0xF, true));
  return v;
}
__device__ __forceinline__ float sum32(float v) { v = dpp_row_sum16(v); v += __shfl_xor(v, 16); return v; }
__device__ __forceinline__ float wsum(float v) { v = dpp_row_sum16(v); v += __shfl_xor(v, 16); v += __shfl_xor(v, 32); return v; }
__device__ __forceinline__ float sigmoidf_(float x) { return __builtin_amdgcn_rcpf(1.f + __expf(-x)); }
__device__ __forceinline__ float siluf_(float x) { return x * __builtin_amdgcn_rcpf(1.f + __expf(-x)); }
__device__ __forceinline__ int rowmap(int e, int lane) { return (e & 3) + 8 * (e >> 2) + 4 * (lane >> 5); }
__device__ __forceinline__ f32x16 mfma16(bf16x8 a, bf16x8 b, f32x16 c) {
  return __builtin_amdgcn_mfma_f32_32x32x16_bf16(a, b, c, 0, 0, 0);
}
__device__ __forceinline__ f32x16 zero16() {
  f32x16 z;
#pragma unroll
  for (int e = 0; e < 16; e++) z[e] = 0.f;
  return z;
}
__device__ __forceinline__ const float* xrow(const Params& p, int tok) {
  return tok < NTP ? p.x_prompt + (size_t)tok * 1024 : p.x_sample + (size_t)(tok - NTP) * 1024;
}

__device__ __forceinline__ float transpose_reduce64(float (&v)[64], int lane) {
#pragma unroll
  for (int i = 0; i < 32; i++) { bool hi = lane & 32; float send = hi ? v[i] : v[i + 32]; float keep = hi ? v[i + 32] : v[i]; v[i] = keep + __shfl_xor(send, 32); }
#pragma unroll
  for (int i = 0; i < 16; i++) { bool hi = lane & 16; float send = hi ? v[i] : v[i + 16]; float keep = hi ? v[i + 16] : v[i]; v[i] = keep + __shfl_xor(send, 16); }
#pragma unroll
  for (int i = 0; i < 8; i++) { bool hi = lane & 8; float send = hi ? v[i] : v[i + 8]; float keep = hi ? v[i + 8] : v[i]; v[i] = keep + __shfl_xor(send, 8); }
#pragma unroll
  for (int i = 0; i < 4; i++) { bool hi = lane & 4; float send = hi ? v[i] : v[i + 4]; float keep = hi ? v[i + 4] : v[i]; v[i] = keep + __shfl_xor(send, 4); }
#pragma unroll
  for (int i = 0; i < 2; i++) { bool hi = lane & 2; float send = hi ? v[i] : v[i + 2]; float keep = hi ? v[i + 2] : v[i]; v[i] = keep + __shfl_xor(send, 2); }
  { bool hi = lane & 1; float send = hi ? v[0] : v[1]; float keep = hi ? v[1] : v[0]; v[0] = keep + __shfl_xor(send, 1); }
  return v[0];
}

struct LoadBf16 {
  const u16* A; int lda;
  struct Raw { uint4 v; };
  __device__ __forceinline__ void load(Raw& r, int row, int k) const { r.v = *(const uint4*)(A + (size_t)row * lda + k); }
  __device__ __forceinline__ uint4 cvt(const Raw& r, int row, int k) const { return r.v; }
};
struct LoadF32 {
  const float* A; int lda;
  struct Raw { float4 a, b; };
  __device__ __forceinline__ void load(Raw& r, int row, int k) const {
    const float4* q = (const float4*)(A + (size_t)row * lda + k); r.a = q[0]; r.b = q[1];
  }
  __device__ __forceinline__ uint4 cvt(const Raw& r, int row, int k) const {
    uint4 o; o.x = pack2(r.a.x, r.a.y); o.y = pack2(r.a.z, r.a.w); o.z = pack2(r.b.x, r.b.y); o.w = pack2(r.b.z, r.b.w); return o;
  }
};
struct LoadNormO {
  const u16* O; const u16* G; const float* rstdL; const float* gn;
  struct Raw { uint4 o, g; };
  __device__ __forceinline__ void load(Raw& r, int row, int k) const {
    r.o = *(const uint4*)(O + (size_t)row * 512 + k);
    r.g = *(const uint4*)(G + (size_t)row * 512 + k);
  }
  __device__ __forceinline__ uint4 cvt(const Raw& r, int row, int k) const {
    const float rs = rstdL[row * 4 + (k >> 7)];
    const float4* gq = (const float4*)(gn + (k & 127));
    float4 g0 = gq[0], g1 = gq[1];
    uint4 o;
    o.x = pack2(bflo(r.o.x) * rs * g0.x * bflo(r.g.x), bfhi(r.o.x) * rs * g0.y * bfhi(r.g.x));
    o.y = pack2(bflo(r.o.y) * rs * g0.z * bflo(r.g.y), bfhi(r.o.y) * rs * g0.w * bfhi(r.g.y));
    o.z = pack2(bflo(r.o.z) * rs * g1.x * bflo(r.g.z), bfhi(r.o.z) * rs * g1.y * bfhi(r.g.z));
    o.w = pack2(bflo(r.o.w) * rs * g1.z * bflo(r.g.w), bfhi(r.o.w) * rs * g1.w * bfhi(r.g.w));
    return o;
  }
};
struct LoadNormX {
  const float* X; const float* SSQ; const float* g; u16* Hout;
  struct Raw { float4 a, b; float s; };
  __device__ __forceinline__ void load(Raw& r, int row, int k) const {
    const float4* q = (const float4*)(X + (size_t)row * 1024 + k); r.a = q[0]; r.b = q[1]; r.s = SSQ[row];
  }
  __device__ __forceinline__ uint4 cvt(const Raw& r, int row, int k) const {
    float rs = rsqrtf(r.s * (1.f / 1024.f) + EPSF);
    const float4* gq = (const float4*)(g + k);
    float4 g0 = gq[0], g1 = gq[1];
    uint4 o;
    o.x = pack2(r.a.x * rs * g0.x, r.a.y * rs * g0.y); o.y = pack2(r.a.z * rs * g0.z, r.a.w * rs * g0.w);
    o.z = pack2(r.b.x * rs * g1.x, r.b.y * rs * g1.y); o.w = pack2(r.b.z * rs * g1.z, r.b.w * rs * g1.w);
    if (Hout) *(uint4*)(Hout + (size_t)row * 1024 + k) = o;
    return o;
  }
};

#define GM_LOAD1(kt_, j)                                                                                           \
  al.load(ar##j, lr + 16 * j, (kt_) * 128 + lk);                                                                   \
  br##j = *(const uint4*)(Bt + (size_t)(lr + 16 * j) * ldb + (kt_) * 128 + lk);
#define GM_LOAD(kt_) { GM_LOAD1(kt_, 0) GM_LOAD1(kt_, 1) GM_LOAD1(kt_, 2) GM_LOAD1(kt_, 3) GM_LOAD1(kt_, 4) GM_LOAD1(kt_, 5) GM_LOAD1(kt_, 6) GM_LOAD1(kt_, 7) }
#define GM_STORE1(kt_, An, Bn, j)                                                                                  \
  *(uint4*)&An[(lr + 16 * j) * 136 + lk] = al.cvt(ar##j, lr + 16 * j, (kt_) * 128 + lk);                           \
  *(uint4*)&Bn[(lr + 16 * j) * 136 + lk] = br##j;
#define GM_STORE(kt_, buf_)                                                                                        \
  {                                                                                                                \
    u16* An = As + (buf_) * 128 * 136; u16* Bn = Bs + (buf_) * 128 * 136;                                          \
    GM_STORE1(kt_, An, Bn, 0) GM_STORE1(kt_, An, Bn, 1) GM_STORE1(kt_, An, Bn, 2) GM_STORE1(kt_, An, Bn, 3)        \
    GM_STORE1(kt_, An, Bn, 4) GM_STORE1(kt_, An, Bn, 5) GM_STORE1(kt_, An, Bn, 6) GM_STORE1(kt_, An, Bn, 7)        \
  }
#define GM_FRAG(FA, FB, Ac, Bc, ks)                                                                               \
  FA##0 = *(const bf16x8*)&Ac[(wm * 64 + r) * 136 + (ks) * 16 + hh];                                               \
  FA##1 = *(const bf16x8*)&Ac[(wm * 64 + 32 + r) * 136 + (ks) * 16 + hh];                                          \
  FB##0 = *(const bf16x8*)&Bc[(wn * 64 + r) * 136 + (ks) * 16 + hh];                                               \
  FB##1 = *(const bf16x8*)&Bc[(wn * 64 + 32 + r) * 136 + (ks) * 16 + hh];
#define GM_MFMA4(FA, FB)                                                                                           \
  acc[0][0] = mfma16(FA##0, FB##0, acc[0][0]); acc[0][1] = mfma16(FA##0, FB##1, acc[0][1]);                        \
  acc[1][0] = mfma16(FA##1, FB##0, acc[1][0]); acc[1][1] = mfma16(FA##1, FB##1, acc[1][1]);
#define GM_COMPUTE(buf_)                                                                                           \
  {                                                                                                                \
    const u16* Ac = As + (buf_) * 128 * 136; const u16* Bc = Bs + (buf_) * 128 * 136;                              \
    bf16x8 fa0, fa1, fb0, fb1, ga0, ga1, gb0, gb1;                                                                 \
    GM_FRAG(fa, fb, Ac, Bc, 0)                                                                                     \
    _Pragma("unroll") for (int ks = 0; ks < 8; ks += 2) {                                                          \
      GM_FRAG(ga, gb, Ac, Bc, ks + 1)                                                                              \
      __builtin_amdgcn_sched_barrier(0);                                                                           \
      GM_MFMA4(fa, fb)                                                                                             \
      __builtin_amdgcn_sched_barrier(0);                                                                           \
      if (ks + 2 < 8) { GM_FRAG(fa, fb, Ac, Bc, ks + 2) }                                                          \
      __builtin_amdgcn_sched_barrier(0);                                                                           \
      GM_MFMA4(ga, gb)                                                                                             \
      __builtin_amdgcn_sched_barrier(0);                                                                           \
    }                                                                                                              \
  }
#define GEMM_LDS_BYTES 139264
template <class AL>
__device__ __forceinline__ void gemm_mainloop(f32x16 (&acc)[2][2], const AL& al, const u16* __restrict__ Bt, int ldb, int K, char* smem) {
  const int tid = threadIdx.x, lane = tid & 63, w = tid >> 6;
  const int wm = w >> 1, wn = w & 1;
  const int lr = tid >> 4, lk = (tid & 15) * 8;
  u16* As = (u16*)smem;
  u16* Bs = As + 2 * 128 * 136;
  typename AL::Raw ar0, ar1, ar2, ar3, ar4, ar5, ar6, ar7; uint4 br0, br1, br2, br3, br4, br5, br6, br7;
  const int KT = K >> 7;
  const int r = lane & 31, hh = (lane >> 5) * 8;
  __syncthreads();
  GM_LOAD(0)
  GM_STORE(0, 0)
  __syncthreads();
#pragma unroll 1
  for (int kt = 0; kt < KT; kt += 2) {
    if (kt + 1 < KT) { GM_LOAD(kt + 1) }
    GM_COMPUTE(0)
    if (kt + 1 < KT) { GM_STORE(kt + 1, 1) }
    __syncthreads();
    if (kt + 1 < KT) {
      if (kt + 2 < KT) { GM_LOAD(kt + 2) }
      GM_COMPUTE(1)
      if (kt + 2 < KT) { GM_STORE(kt + 2, 0) }
      __syncthreads();
    }
  }
}
#define GL_DMA(kt_, buf_)                                                                                          \
  {                                                                                                                \
    char* Ab_ = smem + (buf_) * 65536; char* Bb_ = Ab_ + 32768;                                                    \
    _Pragma("unroll") for (int i = 0; i < 8; i++) {                                                                \
      const int rowb = 4 * (i * 4 + w);                                                                            \
      const int row = rowb + (lane >> 4);                                                                          \
      const int c = (lane & 15) ^ (row & 15);                                                                      \
      __builtin_amdgcn_global_load_lds((const unsigned*)(A + (size_t)row * lda + (kt_) * 128 + c * 8), (unsigned*)(Ab_ + rowb * 256), 16, 0, 0); \
      __builtin_amdgcn_global_load_lds((const unsigned*)(Bt + (size_t)row * ldb + (kt_) * 128 + c * 8), (unsigned*)(Bb_ + rowb * 256), 16, 0, 0); \
    }                                                                                                              \
  }
#define GL_FRAG(FA, FB, Ac, Bc, ks)                                                                                \
  {                                                                                                                \
    const int co_ = (((ks) * 2 + hsel) ^ swz) * 8;                                                                 \
    FA##0 = *(const bf16x8*)&Ac[(wm * 64 + r) * 128 + co_];                                                        \
    FA##1 = *(const bf16x8*)&Ac[(wm * 64 + 32 + r) * 128 + co_];                                                   \
    FB##0 = *(const bf16x8*)&Bc[(wn * 64 + r) * 128 + co_];                                                        \
    FB##1 = *(const bf16x8*)&Bc[(wn * 64 + 32 + r) * 128 + co_];                                                   \
  }
#define GL_COMPUTE(buf_)                                                                                           \
  {                                                                                                                \
    const u16* Ac = (const u16*)(smem + (buf_) * 65536); const u16* Bc = Ac + 16384;                               \
    bf16x8 fa0, fa1, fb0, fb1, ga0, ga1, gb0, gb1;                                                                 \
    GL_FRAG(fa, fb, Ac, Bc, 0)                                                                                     \
    _Pragma("unroll") for (int ks = 0; ks < 8; ks += 2) {                                                          \
      GL_FRAG(ga, gb, Ac, Bc, ks + 1)                                                                              \
      __builtin_amdgcn_sched_barrier(0);                                                                           \
      GM_MFMA4(fa, fb)                                                                                             \
      __builtin_amdgcn_sched_barrier(0);                                                                           \
      if (ks + 2 < 8) { GL_FRAG(fa, fb, Ac, Bc, ks + 2) }                                                          \
      __builtin_amdgcn_sched_barrier(0);                                                                           \
      GM_MFMA4(ga, gb)                                                                                             \
      __builtin_amdgcn_sched_barrier(0);                                                                           \
    }                                                                                                              \
  }
__device__ __forceinline__ void gemm_mainloop_dma(f32x16 (&acc)[2][2], const u16* __restrict__ A, int lda, const u16* __restrict__ Bt, int ldb, int K, char* smem) {
  const int tid = threadIdx.x, lane = tid & 63, w = tid >> 6;
  const int wm = w >> 1, wn = w & 1;
  const int KT = K >> 7;
  const int r = lane & 31, hsel = lane >> 5, swz = lane & 15;
  __syncthreads();
  GL_DMA(0, 0)
  asm volatile("s_waitcnt vmcnt(0)" ::: "memory");
  __syncthreads();
#pragma unroll 1
  for (int kt = 0; kt < KT; kt += 2) {
    if (kt + 1 < KT) { GL_DMA(kt + 1, 1) }
    GL_COMPUTE(0)
    asm volatile("s_waitcnt vmcnt(0)" ::: "memory");
    __syncthreads();
    if (kt + 1 < KT) {
      if (kt + 2 < KT) { GL_DMA(kt + 2, 0) }
      GL_COMPUTE(1)
      asm volatile("s_waitcnt vmcnt(0)" ::: "memory");
      __syncthreads();
    }
  }
}
__device__ __forceinline__ void zero_acc(f32x16 (&acc)[2][2]) {
#pragma unroll
  for (int i = 0; i < 2; i++)
#pragma unroll
    for (int j = 0; j < 2; j++) acc[i][j] = zero16();
}

__device__ __forceinline__ void transpose_tile(const float* __restrict__ src, int ldn, int K, u16* __restrict__ dst, int k0, int ns0, int nd0, char* smem, const float* __restrict__ kscale = nullptr) {
  float* t = (float*)smem;
  const int tid = threadIdx.x;
  __syncthreads();
#pragma unroll
  for (int i = 0; i < 4; i++) {
    int idx = tid + 256 * i; int rr = idx >> 4, c4 = (idx & 15) * 4;
    float4 v = nt_load4(src + (size_t)(k0 + rr) * ldn + ns0 + c4);
    if (kscale) { const float sc = kscale[k0 + rr]; v.x *= sc; v.y *= sc; v.z *= sc; v.w *= sc; }
    t[c4 * 65 + rr] = v.x; t[(c4 + 1) * 65 + rr] = v.y; t[(c4 + 2) * 65 + rr] = v.z; t[(c4 + 3) * 65 + rr] = v.w;
  }
  __syncthreads();
  const int n = tid >> 2, kq = (tid & 3) * 16;
  unsigned pk[8];
#pragma unroll
  for (int i = 0; i < 8; i++) pk[i] = pack2(t[n * 65 + kq + 2 * i], t[n * 65 + kq + 2 * i + 1]);
  uint4* d = (uint4*)(dst + (size_t)(nd0 + n) * K + k0 + kq);
  d[0] = make_uint4(pk[0], pk[1], pk[2], pk[3]);
  d[1] = make_uint4(pk[4], pk[5], pk[6], pk[7]);
}
__device__ __forceinline__ void convert_item4(const float* __restrict__ src, u16* __restrict__ dst, size_t item) {
  size_t base = item * 8192 + (size_t)threadIdx.x * 8;
  float4 a[4], b[4];
#pragma unroll
  for (int i = 0; i < 4; i++) { const float4* q = (const float4*)(src + base + i * 2048); a[i] = q[0]; b[i] = q[1]; }
#pragma unroll
  for (int i = 0; i < 4; i++)
    *(uint4*)(dst + base + i * 2048) = make_uint4(pack2(a[i].x, a[i].y), pack2(a[i].z, a[i].w), pack2(b[i].x, b[i].y), pack2(b[i].z, b[i].w));
}
typedef float float2v __attribute__((ext_vector_type(2)));
#define EU_SCALE 64.f
#define EV_SCALE 16.f
__device__ __forceinline__ void convert_item_fp8(const float* __restrict__ src, unsigned char* __restrict__ dst, size_t item, float scale) {
  size_t base = item * 8192 + (size_t)threadIdx.x * 16;
  float4 a[2][4];
#pragma unroll
  for (int i = 0; i < 2; i++) {
    const float4* q = (const float4*)(src + base + i * 4096);
#pragma unroll
    for (int j = 0; j < 4; j++) a[i][j] = nt_load4((const float*)(q + j));
  }
#pragma unroll
  for (int i = 0; i < 2; i++) {
    unsigned o[4];
#pragma unroll
    for (int j = 0; j < 4; j++) {
      int pk = __builtin_amdgcn_cvt_pk_fp8_f32(a[i][j].x * scale, a[i][j].y * scale, 0, false);
      pk = __builtin_amdgcn_cvt_pk_fp8_f32(a[i][j].z * scale, a[i][j].w * scale, pk, true);
      o[j] = (unsigned)pk;
    }
    *(uint4*)(dst + base + i * 4096) = make_uint4(o[0], o[1], o[2], o[3]);
  }
}
__device__ __forceinline__ void convert_item(const float* __restrict__ src, u16* __restrict__ dst, size_t item) {
  size_t base = item * 2048 + (size_t)threadIdx.x * 8;
  const float4* q = (const float4*)(src + base);
  float4 a = q[0], b = q[1];
  *(uint4*)(dst + base) = make_uint4(pack2(a.x, a.y), pack2(a.z, a.w), pack2(b.x, b.y), pack2(b.z, b.w));
}

__device__ __forceinline__ void phase0(const Params& p, char* smem) {
  const int tid = threadIdx.x, lane = tid & 63, w = tid >> 6;
  char* ws = p.ws;
  const int N_IN = 1536, N_BRA = 128, N_BRB = 128, N_OUT = 256, N_Q = 512, N_PG = 256, N_PLE = 64, N_KEYS = 128;
  const int T0 = N_IN, T1 = T0 + N_BRA, T2 = T1 + N_BRB, T3 = T2 + N_OUT, T4 = T3 + N_Q, T5 = T4 + N_PG, T6 = T5 + N_PLE, T7 = T6 + N_KEYS;
  for (int it = blockIdx.x; it < T7; it += gridDim.x) {
    if (it < T0) { int kt = it & 15, nt = it >> 4; int nd0 = nt * 64; int ns0 = nd0 < 4096 ? nd0 : nd0 + 8;
      transpose_tile(p.w_in, 6152, 1024, (u16*)(ws + OFF_WT_IN), kt * 64, ns0, nd0, smem); }
    else if (it < T1) { int i = it - T0; int kt = i & 7, nt = i >> 3; transpose_tile(p.w_br_a, 1024, 512, (u16*)(ws + OFF_WT_BRA), kt * 64, nt * 64, nt * 64, smem); }
    else if (it < T2) { int i = it - T1; int kt = i & 7, nt = i >> 3; transpose_tile(p.w_br_b, 1024, 512, (u16*)(ws + OFF_WT_BRB), kt * 64, nt * 64, nt * 64, smem); }
    else if (it < T3) { int i = it - T2; int kt = i & 15, nt = i >> 4; transpose_tile(p.w_out, 1024, 1024, (u16*)(ws + OFF_WT_OUT), kt * 64, nt * 64, nt * 64, smem); }
    else if (it < T4) { int i = it - T3; int kt = i & 15, nt = i >> 4; transpose_tile(p.peer_wq, 2048, 1024, (u16*)(ws + OFF_WT_Q), kt * 64, nt * 64, nt * 64, smem, p.g_ffn); }
    else if (it < T5) { int i = it - T4; int kt = i & 15, nt = i >> 4; transpose_tile(p.w_ple_gate, 1024, 1024, (u16*)(ws + OFF_WT_PG), kt * 64, nt * 64, nt * 64, smem); }
    else if (it < T6) { int i = it - T5; int kt = i & 3, nt = i >> 2; transpose_tile(p.w_ple, 1024, 256, (u16*)(ws + OFF_WT_PLE), kt * 64, nt * 64, nt * 64, smem); }
    else { convert_item(p.peer_keys, (u16*)(ws + OFF_KEYS), it - T6); }
  }
  __syncthreads();
  float* w8 = (float*)smem;
  for (int i = tid; i < 2048; i += 256) {
    int k = i >> 1, half = i & 1;
    *(float4*)&w8[k * 8 + half * 4] = *(const float4*)(p.w_in + (size_t)k * 6152 + 4096 + half * 4);
  }
  __syncthreads();
  u16* H = (u16*)(ws + OFF_H);
  float* BETA = (float*)(ws + OFF_BETA); float* GLOG = (float*)(ws + OFF_GLOG);
  float* SSQ1 = (float*)(ws + OFF_SSQ1); float* SSQ3 = (float*)(ws + OFF_SSQ3);
  for (int it = blockIdx.x; it < NT / 4; it += gridDim.x) {
    const int row = it * 4 + w;
    const float* xr = xrow(p, row);
    float4 xv[4]; float ss = 0.f;
#pragma unroll
    for (int i = 0; i < 4; i++) { xv[i] = *(const float4*)(xr + i * 256 + lane * 4); ss += xv[i].x * xv[i].x + xv[i].y * xv[i].y + xv[i].z * xv[i].z + xv[i].w * xv[i].w; }
    ss = wsum(ss);
    const float rs = rsqrtf(ss * (1.f / 1024.f) + EPSF);
    float d8[8];
#pragma unroll
    for (int j = 0; j < 8; j++) d8[j] = 0.f;
#pragma unroll
    for (int i = 0; i < 4; i++) {
      const int k = i * 256 + lane * 4;
      float4 g = *(const float4*)(p.g_mix + k);
      float hv[4] = {xv[i].x * rs * g.x, xv[i].y * rs * g.y, xv[i].z * rs * g.z, xv[i].w * rs * g.w};
      *(uint2*)(H + (size_t)row * 1024 + k) = make_uint2(pack2(hv[0], hv[1]), pack2(hv[2], hv[3]));
#pragma unroll
      for (int q = 0; q < 4; q++) {
        float4 wa = *(const float4*)&w8[(k + q) * 8], wb = *(const float4*)&w8[(k + q) * 8 + 4];
        d8[0] += hv[q] * wa.x; d8[1] += hv[q] * wa.y; d8[2] += hv[q] * wa.z; d8[3] += hv[q] * wa.w;
        d8[4] += hv[q] * wb.x; d8[5] += hv[q] * wb.y; d8[6] += hv[q] * wb.z; d8[7] += hv[q] * wb.w;
      }
    }
#pragma unroll
    for (int j = 0; j < 8; j++) d8[j] = wsum(d8[j]);
    if (lane < 4) {
      float bb = lane == 0 ? d8[0] : lane == 1 ? d8[1] : lane == 2 ? d8[2] : d8[3];
      float ab = lane == 0 ? d8[4] : lane == 1 ? d8[5] : lane == 2 ? d8[6] : d8[7];
      BETA[row * 4 + lane] = sigmoidf_(bb);
      float z = ab + p.dt_bias[lane];
      float sp = z > 20.f ? z : log1pf(expf(z));
      GLOG[row * 4 + lane] = -expf(p.a_log[lane]) * sp;
    }
    if (lane == 0) { SSQ1[row] = 0.f; SSQ3[row] = 0.f; }
  }
}

__device__ __forceinline__ void phase1(const Params& p, char* smem) {
  const int tid = threadIdx.x, lane = tid & 63, w = tid >> 6, wm = w >> 1, wn = w & 1;
  char* ws = p.ws;
  const u16* H = (const u16*)(ws + OFF_H);
  const u16* WT = (const u16*)(ws + OFF_WT_IN);
  u16* QA = (u16*)((char*)p.out + OUTB_QA); u16* RAW = (u16*)((char*)p.out + OUTB_RAW);
  float* LOGF = (float*)(ws + OFF_LOGF); u16* VA = (u16*)(ws + OFF_VA);
  u16* OGA = (u16*)(ws + OFF_OGA); u16* ZB = (u16*)(ws + OFF_ZB);
  const int NTILES = 132 * 32;
  for (int it = blockIdx.x; it < NTILES; it += gridDim.x) {
    const int nt = it & 31, mt = it >> 5;
    const int m0 = mt * 128, n0 = nt * 128;
    f32x16 acc[2][2]; zero_acc(acc);
    gemm_mainloop_dma(acc, H + (size_t)m0 * 1024, 1024, WT + (size_t)n0 * 1024, 1024, 1024, smem);
    const int seg = nt >> 2, cb = (nt & 3) * 128;
    if (seg == 1) {
      float* T32 = (float*)smem;
#pragma unroll
      for (int i = 0; i < 2; i++)
#pragma unroll
        for (int j = 0; j < 2; j++) {
          const int cl = wn * 64 + j * 32 + (lane & 31);
          const float p0 = p.lb_param[cb + cl], p1 = p.lb_param[512 + cb + cl];
          const float lb = 1.f / (1.f + __expf(p1 - p0));
#pragma unroll
          for (int e = 0; e < 16; e++) {
            const float f = lb + (1.f - lb) * sigmoidf_(acc[i][j][e]);
            T32[(wm * 64 + i * 32 + rowmap(e, lane)) * 132 + cl] = __logf(f);
          }
        }
      __syncthreads();
#pragma unroll
      for (int q = 0; q < 16; q++) {
        const int idx = tid + 256 * q, row = idx >> 5, c4 = idx & 31;
        *(float4*)(LOGF + (size_t)(m0 + row) * 512 + cb + c4 * 4) = *(const float4*)&T32[row * 132 + c4 * 4];
      }
    } else {
      u16* T = (u16*)smem;
      const bool act = (seg == 0 || seg == 3 || seg == 7);
#pragma unroll
      for (int i = 0; i < 2; i++)
#pragma unroll
        for (int j = 0; j < 2; j++) {
          const int cl = wn * 64 + j * 32 + (lane & 31);
#pragma unroll
          for (int e = 0; e < 16; e++) {
            const float v = acc[i][j][e];
            const int rl = wm * 64 + i * 32 + rowmap(e, lane);
            T[rl * 136 + cl] = f2bf(act ? siluf_(v) : v);
            if (seg >= 4 && seg <= 6) {
              const int row = m0 + rl; const int ch = (seg - 4) * 512 + cb + cl;
              if (row < NTP) { int t = row & 2047; if (t >= 2045) p.out[OUT_CP + ((size_t)(row >> 11) * 3 + (t - 2045)) * 1536 + ch] = v; }
              else { int rs = row - NTP; int t = rs & 3; if (t >= 1) p.out[OUT_CS + ((size_t)(rs >> 2) * 3 + (t - 1)) * 1536 + ch] = v; }
            }
          }
        }
      __syncthreads();
      u16* dst; int ld;
      if (seg == 0) { dst = QA + cb; ld = 512; }
      else if (seg == 2) { dst = VA + cb; ld = 512; }
      else if (seg == 3) { dst = OGA + cb; ld = 512; }
      else if (seg == 7) { dst = ZB + cb; ld = 512; }
      else { dst = RAW + (seg - 4) * 512 + cb; ld = 1536; }
#pragma unroll
      for (int q = 0; q < 8; q++) {
        const int idx = tid + 256 * q, row = idx >> 4, c8 = idx & 15;
        *(uint4*)(dst + (size_t)(m0 + row) * ld + c8 * 8) = *(const uint4*)&T[row * 136 + c8 * 8];
      }
    }
  }
}

__device__ __forceinline__ void gdn_chunk_item(const Params& p, int item, char* smem) {
  const int tid = threadIdx.x, lane = tid & 63, w = tid >> 6;
  const int n = item & 31, bh = item >> 5, h = bh & 3, b = bh >> 2;
  const int tok0 = b * 2048 + n * 64;
  const int ci = 1024 + item;
  char* ws = p.ws;
  u16* Qs = (u16*)smem;
  u16* Ks = (u16*)(smem + 18432);
  float* Ls = (float*)(smem + 36864);
  u16* QKs = (u16*)(smem + 55296);
  float* sm_g = (float*)(smem + 64512);
  float* sm_bt = sm_g + 64; float* sm_gc = sm_g + 128; float* sm_eg = sm_g + 192; float* sm_red = sm_g + 256;
  float* Xs = (float*)(smem + 66560);
  const u16* RAW = (const u16*)((const char*)p.out + OUTB_RAW);
  u16* QB = (u16*)(ws + OFF_QB) + (size_t)ci * 8192;
  u16* KT = (u16*)(ws + OFF_KT) + (size_t)ci * 8192;
  u16* VT = (u16*)(ws + OFF_VT) + (size_t)ci * 8192;
  u16* PN = (u16*)(ws + OFF_PN) + (size_t)item * 16384;
  u16* Oo = (u16*)(ws + OFF_O) + (size_t)NT * 512;
  __syncthreads();
  if (tid < 64) {
    float g = ((const float*)(ws + OFF_GLOG))[(size_t)(tok0 + tid) * 4 + h];
    float bt = ((const float*)(ws + OFF_BETA))[(size_t)(tok0 + tid) * 4 + h];
    float c = g;
#pragma unroll
    for (int o = 1; o < 64; o <<= 1) { float t = __shfl_up(c, o); if (lane >= o) c += t; }
    sm_g[tid] = g; sm_bt[tid] = bt; sm_gc[tid] = c; sm_eg[tid] = __expf(c);
  }
  __syncthreads();
  const float gl = sm_gc[63];
  const int type = tid >> 7, c = tid & 127;
  float val[64];
  float vv[64];
  {
    u16* tile = (u16*)Xs;
    for (int i = tid; i < 67 * 48; i += 256) {
      const int row = i / 48, rem = i - row * 48, seg = rem >> 4, c8 = rem & 15;
      uint4 v4 = make_uint4(0, 0, 0, 0);
      if (n > 0 || row >= 3) v4 = *(const uint4*)(RAW + (size_t)(tok0 - 3 + row) * 1536 + seg * 512 + h * 128 + c8 * 8);
      *(uint4*)&tile[row * 384 + seg * 128 + c8 * 8] = v4;
    }
    __syncthreads();
    {
      const int col = type * 512 + h * 128 + c;
      const float w0 = p.conv_w[col], w1 = p.conv_w[1536 + col], w2 = p.conv_w[3072 + col], w3 = p.conv_w[4608 + col];
      const u16* tp = tile + type * 128 + c;
      float x0 = bf2f(tp[0]), x1 = bf2f(tp[384]), x2 = bf2f(tp[768]);
#pragma unroll
      for (int t = 0; t < 64; t++) {
        float x3 = bf2f(tp[(t + 3) * 384]);
        float cv = x0 * w0 + x1 * w1 + x2 * w2 + x3 * w3;
        val[t] = siluf_(cv);
        x0 = x1; x1 = x2; x2 = x3;
      }
    }
    float sq[64];
#pragma unroll
    for (int t = 0; t < 64; t++) sq[t] = val[t] * val[t];
    float part = transpose_reduce64(sq, lane);
    sm_red[(type * 2 + (w & 1)) * 64 + lane] = part;
  }
  __syncthreads();
  {
    u16* Xs = type ? Ks : Qs;
    const float sc = type ? 1.f : 0.08838834764831845f;
#pragma unroll
    for (int t = 0; t < 64; t++) {
      float rn = rsqrtf(sm_red[(type * 2) * 64 + t] + sm_red[(type * 2 + 1) * 64 + t] + EPSF) * sc;
      val[t] *= rn;
      Xs[t * 136 + c] = f2bf(val[t]);
    }
  }
  {
    const u16* tile = (const u16*)Xs;
  if (type == 0) {
    const int col = 1024 + h * 128 + c;
    const float w0 = p.conv_w[col], w1 = p.conv_w[1536 + col], w2 = p.conv_w[3072 + col], w3 = p.conv_w[4608 + col];
    const u16* tp = tile + 256 + c;
    float x0 = bf2f(tp[0]), x1 = bf2f(tp[384]), x2 = bf2f(tp[768]);
#pragma unroll
    for (int t = 0; t < 64; t++) {
      float x3 = bf2f(tp[(t + 3) * 384]);
      float cv = x0 * w0 + x1 * w1 + x2 * w2 + x3 * w3;
      vv[t] = siluf_(cv) * sm_bt[t];
      x0 = x1; x1 = x2; x2 = x3;
    }
  }
  }
  __syncthreads();
#pragma unroll
  for (int q = 0; q < 4; q++) {
    const int idx = tid + 256 * q, row = idx >> 4, c8 = idx & 15;
    const uint4 v4 = *(const uint4*)&Qs[row * 136 + c8 * 8];
    const float eg = sm_eg[row];
    *(uint4*)&QB[row * 128 + c8 * 8] = make_uint4(pack2(bflo(v4.x) * eg, bfhi(v4.x) * eg), pack2(bflo(v4.y) * eg, bfhi(v4.y) * eg),
                                                   pack2(bflo(v4.z) * eg, bfhi(v4.z) * eg), pack2(bflo(v4.w) * eg, bfhi(v4.w) * eg));
  }
  {
    const int mi = w >> 1, ni = w & 1, r = lane & 31, hh = (lane >> 5) * 8;
    f32x16 kk = zero16(), qk = zero16();
#pragma unroll
    for (int ks = 0; ks < 8; ks++) {
      bf16x8 ak = *(const bf16x8*)&Ks[(mi * 32 + r) * 136 + ks * 16 + hh];
      bf16x8 bk = *(const bf16x8*)&Ks[(ni * 32 + r) * 136 + ks * 16 + hh];
      bf16x8 aq = *(const bf16x8*)&Qs[(mi * 32 + r) * 136 + ks * 16 + hh];
      kk = mfma16(ak, bk, kk); qk = mfma16(aq, bk, qk);
    }
    const int s = ni * 32 + r; const float gcs = sm_gc[s];
#pragma unroll
    for (int e = 0; e < 16; e++) {
      const int t = mi * 32 + rowmap(e, lane);
      float gam = (s <= t) ? __expf(sm_gc[t] - gcs) : 0.f;
      Ls[t * 68 + s] = (s < t) ? sm_bt[t] * gam * kk[e] : 0.f;
      QKs[t * 72 + s] = f2bf(qk[e] * gam);
    }
  }
  __syncthreads();
  if (type == 1) {
    u16* kdT = Qs;
    unsigned pk[32];
#pragma unroll
    for (int s2 = 0; s2 < 32; s2++) pk[s2] = pack2(val[2 * s2] * __expf(gl - sm_gc[2 * s2]), val[2 * s2 + 1] * __expf(gl - sm_gc[2 * s2 + 1]));
#pragma unroll
    for (int q = 0; q < 8; q++) {
      uint4 v4 = make_uint4(pk[4 * q], pk[4 * q + 1], pk[4 * q + 2], pk[4 * q + 3]);
      *(uint4*)&kdT[c * 72 + q * 8] = v4;
      *(uint4*)&KT[c * 64 + q * 8] = v4;
    }
#pragma unroll
    for (int t = 0; t < 64; t++) Xs[t * 256 + tid] = sm_bt[t] * sm_eg[t] * val[t];
  } else {
#pragma unroll
    for (int t = 0; t < 64; t++) Xs[t * 256 + tid] = vv[t];
  }
  {
    float* xc = Xs + tid;
#pragma unroll 1
    for (int b4 = 0; b4 < 16; b4++) {
      const int t0 = b4 * 4;
      float a0 = xc[t0 * 256], a1 = xc[(t0 + 1) * 256], a2 = xc[(t0 + 2) * 256], a3 = xc[(t0 + 3) * 256];
      const float* l0p = Ls + t0 * 68;
#pragma unroll 2
      for (int sg = 0; sg < b4; sg++) {
        const float4 l0 = *(const float4*)&l0p[sg * 4], l1 = *(const float4*)&l0p[68 + sg * 4];
        const float4 l2 = *(const float4*)&l0p[136 + sg * 4], l3 = *(const float4*)&l0p[204 + sg * 4];
        const float* xp = xc + sg * 1024;
        const float x0 = xp[0], x1 = xp[256], x2 = xp[512], x3 = xp[768];
        a0 -= l0.x * x0; a0 -= l0.y * x1; a0 -= l0.z * x2; a0 -= l0.w * x3;
        a1 -= l1.x * x0; a1 -= l1.y * x1; a1 -= l1.z * x2; a1 -= l1.w * x3;
        a2 -= l2.x * x0; a2 -= l2.y * x1; a2 -= l2.z * x2; a2 -= l2.w * x3;
        a3 -= l3.x * x0; a3 -= l3.y * x1; a3 -= l3.z * x2; a3 -= l3.w * x3;
      }
      const float4 d1 = *(const float4*)&l0p[68 + t0], d2 = *(const float4*)&l0p[136 + t0], d3 = *(const float4*)&l0p[204 + t0];
      a1 -= d1.x * a0;
      a2 -= d2.x * a0; a2 -= d2.y * a1;
      a3 -= d3.x * a0; a3 -= d3.y * a1; a3 -= d3.z * a2;
      xc[t0 * 256] = a0; xc[(t0 + 1) * 256] = a1; xc[(t0 + 2) * 256] = a2; xc[(t0 + 3) * 256] = a3;
    }
#pragma unroll
    for (int t = 0; t < 64; t++) val[t] = xc[t * 256];
  }
  __syncthreads();
  {
    u16* dstL = type == 0 ? (u16*)Ls : Ks;
#pragma unroll
    for (int q = 0; q < 8; q++) {
      uint4 v4 = make_uint4(pack2(val[8 * q], val[8 * q + 1]), pack2(val[8 * q + 2], val[8 * q + 3]), pack2(val[8 * q + 4], val[8 * q + 5]), pack2(val[8 * q + 6], val[8 * q + 7]));
      *(uint4*)&dstL[c * 72 + q * 8] = v4;
      if (type == 0) *(uint4*)&VT[c * 64 + q * 8] = v4;
    }
  }
  __syncthreads();
  {
    const u16* U0T = (const u16*)Ls; const u16* WTl = Ks; const u16* kdT = Qs;
    u16* O0T = (u16*)Xs; u16* QWT = O0T + 64 * 136; u16* PNT = QWT + 64 * 136;
    const int r = lane & 31, hh = (lane >> 5) * 8;
    const int mi = w & 1, ni0 = (w >> 1) * 2;
#pragma unroll
    for (int jj = 0; jj < 2; jj++) {
      const int ni = ni0 + jj;
      f32x16 o0 = zero16(), qw = zero16();
#pragma unroll
      for (int ks = 0; ks < 4; ks++) {
        bf16x8 a = *(const bf16x8*)&QKs[(mi * 32 + r) * 72 + ks * 16 + hh];
        bf16x8 bu = *(const bf16x8*)&U0T[(ni * 32 + r) * 72 + ks * 16 + hh];
        bf16x8 bw = *(const bf16x8*)&WTl[(ni * 32 + r) * 72 + ks * 16 + hh];
        o0 = mfma16(a, bu, o0); qw = mfma16(a, bw, qw);
      }
      const int col = ni * 32 + r;
#pragma unroll
      for (int e = 0; e < 16; e++) {
        const int t = mi * 32 + rowmap(e, lane);
        O0T[t * 136 + col] = f2bf(o0[e]);
        QWT[t * 136 + col] = f2bf(qw[e]);
      }
    }
#pragma unroll
    for (int ni = 0; ni < 4; ni++) {
      f32x16 pn = zero16();
#pragma unroll
      for (int ks = 0; ks < 4; ks++) {
        bf16x8 a = *(const bf16x8*)&kdT[(w * 32 + r) * 72 + ks * 16 + hh];
        bf16x8 bw = *(const bf16x8*)&WTl[(ni * 32 + r) * 72 + ks * 16 + hh];
        pn = mfma16(a, bw, pn);
      }
#pragma unroll
      for (int e = 0; e < 16; e++) PNT[(w * 32 + rowmap(e, lane)) * 136 + ni * 32 + r] = f2bf(-pn[e]);
    }
    if (tid < 128) ((float*)(ws + OFF_DVEC))[(size_t)ci * 128 + tid] = __expf(gl);
    __syncthreads();
#pragma unroll
    for (int q = 0; q < 4; q++) {
      const int idx = tid + 256 * q, row = idx >> 4, c8 = idx & 15;
      *(uint4*)&Oo[(size_t)(tok0 + row) * 512 + h * 128 + c8 * 8] = *(const uint4*)&O0T[row * 136 + c8 * 8];
      const uint4 a4 = *(const uint4*)&QB[row * 128 + c8 * 8];
      const uint4 w4 = *(const uint4*)&QWT[row * 136 + c8 * 8];
      *(uint4*)&QB[row * 128 + c8 * 8] = make_uint4(pack2(bflo(a4.x) - bflo(w4.x), bfhi(a4.x) - bfhi(w4.x)), pack2(bflo(a4.y) - bflo(w4.y), bfhi(a4.y) - bfhi(w4.y)),
                                                     pack2(bflo(a4.z) - bflo(w4.z), bfhi(a4.z) - bfhi(w4.z)), pack2(bflo(a4.w) - bflo(w4.w), bfhi(a4.w) - bfhi(w4.w)));
    }
#pragma unroll
    for (int q = 0; q < 8; q++) {
      const int idx = tid + 256 * q, row = idx >> 4, c8 = idx & 15;
      *(uint4*)&PN[row * 128 + c8 * 8] = *(const uint4*)&PNT[row * 136 + c8 * 8];
    }
  }
}

__device__ __forceinline__ void hgrn_chunk_item(const Params& p, int item, char* smem) {
  const int tid = threadIdx.x, lane = tid & 63, w = tid >> 6;
  const int n = item & 31, bh = item >> 5, h = bh & 3, b = bh >> 2;
  const int tok0 = b * 2048 + n * 64;
  const int ci = item;
  char* ws = p.ws;
  u16* Qt = (u16*)smem;
  u16* Kt = (u16*)(smem + 17408);
  u16* ATT = (u16*)(smem + 34816);
  u16* VTs = (u16*)(smem + 44032);
  const float* LOGF = (const float*)(ws + OFF_LOGF);
  const u16* QA = (const u16*)((const char*)p.out + OUTB_QA);
  const u16* VA = (const u16*)(ws + OFF_VA);
  u16* QB = (u16*)(ws + OFF_QB) + (size_t)ci * 8192;
  u16* KT = (u16*)(ws + OFF_KT) + (size_t)ci * 8192;
  u16* VT = (u16*)(ws + OFF_VT) + (size_t)ci * 8192;
  u16* Oo = (u16*)(ws + OFF_O);
  __syncthreads();
  const int d = tid & 127, half = tid >> 7;
  const int colb = h * 128 + d;
  float* LFs = (float*)(smem + 62464);
  u16* QAs = (u16*)(smem + 95232);
  u16* VAs = (u16*)(smem + 111616);
  u16* OT = (u16*)LFs;
  {
#pragma unroll
    for (int q = 0; q < 8; q++) {
      const int i = tid + 256 * q; const int row = i >> 5, c4 = i & 31;
      *(float4*)&LFs[row * 128 + c4 * 4] = *(const float4*)(LOGF + (size_t)(tok0 + row) * 512 + h * 128 + c4 * 4);
    }
#pragma unroll
    for (int q = 0; q < 4; q++) {
      const int i = tid + 256 * q; const int row = i >> 4, c8 = i & 15;
      *(uint4*)&QAs[row * 128 + c8 * 8] = *(const uint4*)(QA + (size_t)(tok0 + row) * 512 + h * 128 + c8 * 8);
      *(uint4*)&VAs[row * 128 + c8 * 8] = *(const uint4*)(VA + (size_t)(tok0 + row) * 512 + h * 128 + c8 * 8);
    }
  }
  __syncthreads();
  float bc[64];
  {
    float run = 0.f;
#pragma unroll
    for (int t = 0; t < 64; t++) { run += LFs[t * 128 + d]; bc[t] = run; }
  }
  const float rref = bc[31], bl = bc[63];
  if (half == 0) {
#pragma unroll
    for (int t = 0; t < 64; t++) {
      float q = bf2f(QAs[t * 128 + d]);
      Qt[t * 136 + d] = f2bf(q * __expf(bc[t] - rref));
      QAs[t * 128 + d] = f2bf(q * __expf(bc[t]));
    }
    ((float*)(ws + OFF_DVEC))[(size_t)ci * 128 + d] = __expf(bl);
  } else {
    unsigned pk[32];
    float kprev = 0.f;
#pragma unroll
    for (int t = 0; t < 64; t++) {
      float lf2 = LFs[t * 128 + d];
      float k = 1.f - __expf(lf2);
      Kt[t * 136 + d] = f2bf(k * __expf(rref - bc[t]));
      float kh = k * __expf(bl - bc[t]);
      if (t & 1) pk[t >> 1] = pack2(kprev, kh); else kprev = kh;
    }
#pragma unroll
    for (int q = 0; q < 8; q++) *(uint4*)&KT[d * 64 + q * 8] = make_uint4(pk[4 * q], pk[4 * q + 1], pk[4 * q + 2], pk[4 * q + 3]);
  }
  {
    unsigned pk[16];
#pragma unroll
    for (int s2 = 0; s2 < 16; s2++) {
      u16 a = VAs[(half * 32 + 2 * s2) * 128 + d];
      u16 b2 = VAs[(half * 32 + 2 * s2 + 1) * 128 + d];
      pk[s2] = (unsigned)a | ((unsigned)b2 << 16);
    }
#pragma unroll
    for (int q = 0; q < 4; q++) {
      uint4 v4 = make_uint4(pk[4 * q], pk[4 * q + 1], pk[4 * q + 2], pk[4 * q + 3]);
      *(uint4*)&VTs[d * 72 + half * 32 + q * 8] = v4;
      *(uint4*)&VT[d * 64 + half * 32 + q * 8] = v4;
    }
  }
  __syncthreads();
#pragma unroll
  for (int q = 0; q < 4; q++) {
    const int idx = tid + 256 * q, row = idx >> 4, c8 = idx & 15;
    *(uint4*)&QB[row * 128 + c8 * 8] = *(const uint4*)&QAs[row * 128 + c8 * 8];
  }
  {
    const int mi = w >> 1, ni = w & 1, r = lane & 31, hh = (lane >> 5) * 8;
    f32x16 at = zero16();
#pragma unroll
    for (int ks = 0; ks < 8; ks++) {
      bf16x8 a = *(const bf16x8*)&Qt[(mi * 32 + r) * 136 + ks * 16 + hh];
      bf16x8 bb = *(const bf16x8*)&Kt[(ni * 32 + r) * 136 + ks * 16 + hh];
      at = mfma16(a, bb, at);
    }
    const int s = ni * 32 + r;
#pragma unroll
    for (int e = 0; e < 16; e++) { const int t = mi * 32 + rowmap(e, lane); ATT[t * 72 + s] = f2bf(s <= t ? at[e] : 0.f); }
  }
  __syncthreads();
  {
    const int r = lane & 31, hh = (lane >> 5) * 8;
    const int mi = w & 1, ni0 = (w >> 1) * 2;
#pragma unroll
    for (int jj = 0; jj < 2; jj++) {
      const int ni = ni0 + jj;
      f32x16 o0 = zero16();
#pragma unroll
      for (int ks = 0; ks < 4; ks++) {
        bf16x8 a = *(const bf16x8*)&ATT[(mi * 32 + r) * 72 + ks * 16 + hh];
        bf16x8 bv = *(const bf16x8*)&VTs[(ni * 32 + r) * 72 + ks * 16 + hh];
        o0 = mfma16(a, bv, o0);
      }
#pragma unroll
      for (int e = 0; e < 16; e++) OT[(mi * 32 + rowmap(e, lane)) * 136 + ni * 32 + r] = f2bf(o0[e]);
    }
    __syncthreads();
#pragma unroll
    for (int q = 0; q < 4; q++) {
      const int idx = tid + 256 * q, row = idx >> 4, c8 = idx & 15;
      *(uint4*)&Oo[(size_t)(tok0 + row) * 512 + h * 128 + c8 * 8] = *(const uint4*)&OT[row * 136 + c8 * 8];
    }
  }
}

__device__ __forceinline__ void hgrn_sample_item(const Params& p, int item, char* smem) {
  const int tid = threadIdx.x, lane = tid & 63, w = tid >> 6;
  const int bs = item >> 2, h = item & 3;
  char* ws = p.ws;
  float* fq = (float*)smem;
  float* ff = fq + 512; float* fk = ff + 512; float* fv = fk + 512; float* part = fv + 512;
  float* red = part + 256;
  const float* LOGF = (const float*)(ws + OFF_LOGF);
  const u16* QA = (const u16*)((const char*)p.out + OUTB_QA);
  const u16* VA = (const u16*)(ws + OFF_VA);
  const int tokb = NTP + bs * 4;
  __syncthreads();
  if (tid < 128) {
#pragma unroll
    for (int t = 0; t < 4; t++) {
      size_t idx = (size_t)(tokb + t) * 512 + h * 128 + tid;
      float lf = LOGF[idx];
      ff[t * 128 + tid] = __expf(lf); fk[t * 128 + tid] = -expm1f(lf);
      fq[t * 128 + tid] = bf2f(QA[idx]); fv[t * 128 + tid] = bf2f(VA[idx]);
    }
  }
  __syncthreads();
  const int v = tid & 127, dh = tid >> 7;
  const float* s0 = p.state_hgrn + ((size_t)(bs * 4 + h) * 128 + dh * 64) * 128 + v;
  float S[64];
#pragma unroll
  for (int i = 0; i < 64; i++) S[i] = s0[(size_t)i * 128];
  float o4[4];
#pragma unroll
  for (int t = 0; t < 4; t++) {
    float os = 0.f; const float vv = fv[t * 128 + v];
#pragma unroll
    for (int i = 0; i < 64; i++) {
      const int dd = dh * 64 + i;
      S[i] = ff[t * 128 + dd] * S[i] + fk[t * 128 + dd] * vv;
      os += S[i] * fq[t * 128 + dd];
    }
    part[dh * 128 + v] = os;
    __syncthreads();
    o4[t] = part[v] + part[128 + v];
    __syncthreads();
  }
  float* so = p.out + OUT_HS + ((size_t)(bs * 4 + h) * 128 + dh * 64) * 128 + v;
#pragma unroll
  for (int i = 0; i < 64; i++) so[(size_t)i * 128] = S[i];
  u16* Oo = (u16*)(ws + OFF_O);
  float* SSQO = (float*)(ws + OFF_SSQO);
  if (dh == 0) {
#pragma unroll
    for (int t = 0; t < 4; t++) {
      Oo[(size_t)(tokb + t) * 512 + h * 128 + v] = f2bf(o4[t]);
      float s = wsum(o4[t] * o4[t]);
      if (lane == 0) red[t * 2 + w] = s;
    }
  }
  __syncthreads();
  if (tid < 4) {
    float* q = SSQO + ((size_t)(tokb + tid) * 4 + h) * 4;
    q[0] = red[tid * 2] + red[tid * 2 + 1]; q[1] = 0.f; q[2] = 0.f; q[3] = 0.f;
  }
}

__device__ __forceinline__ void gdn_sample_item(const Params& p, int item, char* smem) {
  const int tid = threadIdx.x, lane = tid & 63, w = tid >> 6;
  const int bs = item >> 2, h = item & 3;
  char* ws = p.ws;
  float* cq = (float*)smem;
  float* ck = cq + 512; float* cv = ck + 512; float* part = cv + 512;
  float* red = part + 256;
  float* sg = red + 16;
  const u16* RAW = (const u16*)((const char*)p.out + OUTB_RAW);
  const int tokb = NTP + bs * 4;
  __syncthreads();
  float cval[4];
  {
    const int type = tid >> 7, c = tid & 127;
    const int col = type * 512 + h * 128 + c;
    const float w0 = p.conv_w[col], w1 = p.conv_w[1536 + col], w2 = p.conv_w[3072 + col], w3 = p.conv_w[4608 + col];
    const float* sc = p.state_conv + (size_t)bs * 3 * 1536 + col;
    float x0 = sc[0], x1 = sc[1536], x2 = sc[3072];
#pragma unroll
    for (int t = 0; t < 4; t++) {
      float x3 = bf2f(RAW[(size_t)(tokb + t) * 1536 + col]);
      float c4 = x0 * w0 + x1 * w1 + x2 * w2 + x3 * w3;
      cval[t] = siluf_(c4);
      x0 = x1; x1 = x2; x2 = x3;
      float s = wsum(cval[t] * cval[t]);
      if (lane == 0) red[t * 4 + w] = s;
    }
  }
  if (tid < 128) {
    const int col = 1024 + h * 128 + tid;
    const float w0 = p.conv_w[col], w1 = p.conv_w[1536 + col], w2 = p.conv_w[3072 + col], w3 = p.conv_w[4608 + col];
    const float* sc = p.state_conv + (size_t)bs * 3 * 1536 + col;
    float x0 = sc[0], x1 = sc[1536], x2 = sc[3072];
#pragma unroll
    for (int t = 0; t < 4; t++) {
      float x3 = bf2f(RAW[(size_t)(tokb + t) * 1536 + col]);
      float c4 = x0 * w0 + x1 * w1 + x2 * w2 + x3 * w3;
      cv[t * 128 + tid] = siluf_(c4);
      x0 = x1; x1 = x2; x2 = x3;
    }
  }
  if (tid < 4) {
    sg[tid] = __expf(((const float*)(ws + OFF_GLOG))[(size_t)(tokb + tid) * 4 + h]);
    sg[4 + tid] = ((const float*)(ws + OFF_BETA))[(size_t)(tokb + tid) * 4 + h];
  }
  __syncthreads();
  {
    const int type = tid >> 7, c = tid & 127;
    float* dst = type ? ck : cq;
#pragma unroll
    for (int t = 0; t < 4; t++) {
      float rn = rsqrtf(red[t * 4 + type * 2] + red[t * 4 + type * 2 + 1] + EPSF);
      if (type == 0) rn *= 0.08838834764831845f;
      dst[t * 128 + c] = cval[t] * rn;
    }
  }
  __syncthreads();
  const int v = tid & 127, dh = tid >> 7;
  const float* s0 = p.state_delta + ((size_t)(bs * 4 + h) * 128 + dh * 64) * 128 + v;
  float S[64];
#pragma unroll
  for (int i = 0; i < 64; i++) S[i] = s0[(size_t)i * 128];
  float o4[4];
#pragma unroll
  for (int t = 0; t < 4; t++) {
    const float a = sg[t], bt = sg[4 + t];
    float ks = 0.f;
#pragma unroll
    for (int i = 0; i < 64; i++) ks += ck[t * 128 + dh * 64 + i] * S[i];
    part[dh * 128 + v] = ks;
    __syncthreads();
    const float kS = part[v] + part[128 + v];
    __syncthreads();
    const float u = bt * (cv[t * 128 + v] - a * kS);
    float os = 0.f;
#pragma unroll
    for (int i = 0; i < 64; i++) {
      const int dd = dh * 64 + i;
      S[i] = a * S[i] + ck[t * 128 + dd] * u;
      os += S[i] * cq[t * 128 + dd];
    }
    part[dh * 128 + v] = os;
    __syncthreads();
    o4[t] = part[v] + part[128 + v];
    __syncthreads();
  }
  float* so = p.out + OUT_DS + ((size_t)(bs * 4 + h) * 128 + dh * 64) * 128 + v;
#pragma unroll
  for (int i = 0; i < 64; i++) so[(size_t)i * 128] = S[i];
  u16* Oo = (u16*)(ws + OFF_O) + (size_t)NT * 512;
  float* SSQO = (float*)(ws + OFF_SSQO) + (size_t)NT * 16;
  if (dh == 0) {
#pragma unroll
    for (int t = 0; t < 4; t++) {
      Oo[(size_t)(tokb + t) * 512 + h * 128 + v] = f2bf(o4[t]);
      float s = wsum(o4[t] * o4[t]);
      if (lane == 0) red[t * 4 + w] = s;
    }
  }
  __syncthreads();
  if (tid < 4) {
    float* q = SSQO + ((size_t)(tokb + tid) * 4 + h) * 4;
    q[0] = red[tid * 4] + red[tid * 4 + 1]; q[1] = 0.f; q[2] = 0.f; q[3] = 0.f;
  }
}

__device__ __forceinline__ void phase2(const Params& p, char* smem, int lo = 0, int hi = 3072) {
  const int g = gridDim.x, bx = blockIdx.x;
#pragma unroll 1
  for (int it = lo + bx; it < hi && it < 1024; it += g) gdn_chunk_item(p, it, smem);
#pragma unroll 1
  for (int it = lo + bx + ((lo < 1024) ? ((1024 - lo - bx + g - 1) / g) * g : 0); it < hi && it < 2048; it += g) if (it >= 1024) hgrn_chunk_item(p, it - 1024, smem);
#pragma unroll 1
  for (int it = lo + bx + ((lo < 2048) ? ((2048 - lo - bx + g - 1) / g) * g : 0); it < hi && it < 2560; it += g) if (it >= 2048) gdn_sample_item(p, it - 2048, smem);
#pragma unroll 1
  for (int it = lo + bx + ((lo < 2560) ? ((2560 - lo - bx + g - 1) / g) * g : 0); it < hi; it += g) if (it >= 2560) hgrn_sample_item(p, it - 2560, smem);
}

__device__ __forceinline__ void seq_item(const Params& p, int item, char* smem, const bool write_o = true) {
  const int tid = threadIdx.x, lane = tid & 63, w = tid >> 6;
  const int m = 1 - (item >> 7); const int rem = item & 127; const int bh = rem >> 2, sl = rem & 3; const int b = bh >> 2, h = bh & 3;
  char* ws = p.ws;
  u16* STs = (u16*)smem;
  u16* VTs = (u16*)(smem + 8704);
  const int r = lane & 31, hh = (lane >> 5) * 8;
  const int dcol = w * 32 + r;
  u16* Om = (u16*)(ws + OFF_O) + (size_t)m * NT * 512;
  float* SSQO = (float*)(ws + OFF_SSQO) + (size_t)m * NT * 16;
  const float* DVEC = (const float*)(ws + OFF_DVEC);
  f32x16 S = zero16();
  __syncthreads();
  uint4 vt4; bf16x8 ktf[4], pnf[8], qbf[8]; float dvn; u16 o0[16];
#define SEQ_LOADS(n_)                                                                                           \
  {                                                                                                             \
    const int ci_ = m * 1024 + bh * 32 + (n_);                                                                  \
    const u16* QB_ = (const u16*)(ws + OFF_QB) + (size_t)ci_ * 8192;                                            \
    const u16* KT_ = (const u16*)(ws + OFF_KT) + (size_t)ci_ * 8192;                                            \
    const u16* VT_ = (const u16*)(ws + OFF_VT) + (size_t)ci_ * 8192;                                            \
    const u16* PN_ = (const u16*)(ws + OFF_PN) + (size_t)(bh * 32 + (n_)) * 16384;                              \
    vt4 = *(const uint4*)(VT_ + (sl * 32 + (tid >> 3)) * 64 + (tid & 7) * 8);                                   \
    dvn = DVEC[(size_t)ci_ * 128 + dcol];                                                                       \
    _Pragma("unroll") for (int ks = 0; ks < 4; ks++) ktf[ks] = *(const bf16x8*)(KT_ + dcol * 64 + ks * 16 + hh); \
    if (m == 1) { _Pragma("unroll") for (int ks = 0; ks < 8; ks++) pnf[ks] = *(const bf16x8*)(PN_ + dcol * 128 + ks * 16 + hh); } \
    if (w < 2) {                                                                                                \
      _Pragma("unroll") for (int ks = 0; ks < 8; ks++) qbf[ks] = *(const bf16x8*)(QB_ + (w * 32 + r) * 128 + ks * 16 + hh); \
      const int tok0_ = b * 2048 + (n_) * 64;                                                                   \
      _Pragma("unroll") for (int e = 0; e < 16; e++) o0[e] = Om[(size_t)(tok0_ + w * 32 + rowmap(e, lane)) * 512 + h * 128 + sl * 32 + r]; \
    }                                                                                                           \
  }
  SEQ_LOADS(0)
#pragma unroll 1
  for (int n = 0; n < 32; n++) {
#pragma unroll
    for (int e = 0; e < 16; e++) STs[rowmap(e, lane) * 136 + dcol] = f2bf(S[e]);
    *(uint4*)&VTs[(tid >> 3) * 72 + (tid & 7) * 8] = vt4;
    __syncthreads();
    const int tok0 = b * 2048 + n * 64;
    if (w < 2) {
      f32x16 o;
#pragma unroll
      for (int e = 0; e < 16; e++) o[e] = bf2f(o0[e]);
#pragma unroll
      for (int ks = 0; ks < 8; ks++) {
        bf16x8 bb = *(const bf16x8*)&STs[r * 136 + ks * 16 + hh];
        o = mfma16(qbf[ks], bb, o);
      }
#pragma unroll
      for (int e = 0; e < 16; e++) {
        const int t = w * 32 + rowmap(e, lane);
        if (write_o) Om[(size_t)(tok0 + t) * 512 + h * 128 + sl * 32 + r] = f2bf(o[e]);
        float sq = sum32(o[e] * o[e]);
        if (r == 0) SSQO[((size_t)(tok0 + t) * 4 + h) * 4 + sl] = sq;
      }
    }
#pragma unroll
    for (int e = 0; e < 16; e++) S[e] *= dvn;
#pragma unroll
    for (int ks = 0; ks < 4; ks++) {
      bf16x8 a = *(const bf16x8*)&VTs[r * 72 + ks * 16 + hh];
      S = mfma16(a, ktf[ks], S);
    }
    if (m == 1) {
#pragma unroll
      for (int ks = 0; ks < 8; ks++) {
        bf16x8 a = *(const bf16x8*)&STs[r * 136 + ks * 16 + hh];
        S = mfma16(a, pnf[ks], S);
      }
    }
    if (n + 1 < 32) SEQ_LOADS(n + 1)
    __syncthreads();
  }
  float* so = p.out + (m == 0 ? OUT_HP : OUT_DP) + (size_t)bh * 16384;
#pragma unroll
  for (int g = 0; g < 4; g++) {
    const int v0 = 8 * g + (lane >> 5) * 4;
    *(float4*)(so + (size_t)dcol * 128 + sl * 32 + v0) = make_float4(S[4 * g], S[4 * g + 1], S[4 * g + 2], S[4 * g + 3]);
  }
}
__device__ __forceinline__ void phase3(const Params& p, char* smem, const bool write_o = true) {
  for (int it = blockIdx.x; it < 256; it += gridDim.x) seq_item(p, it, smem, write_o);
}

__device__ __forceinline__ void phase4a(const Params& p, char* smem) {
  const int tid = threadIdx.x, lane = tid & 63, w = tid >> 6, wm = w >> 1, wn = w & 1;
  char* ws = p.ws;
  const u16* H = (const u16*)(ws + OFF_H);
  const u16* WTIN = (const u16*)(ws + OFF_WT_IN);
  u16* MRG = (u16*)(ws + OFF_MRG);
  const int NG = 132 * 8;
  const int NCONV = 4096;
  float* gnL = (float*)(smem + 141312);
  if (tid < 128) { gnL[tid] = p.g_norm_a[tid]; gnL[128 + tid] = p.g_norm_b[tid]; }
  __syncthreads();
  const int G = (int)gridDim.x;
  const int nfull = NG / G;
  const int nleft = NG - nfull * G;
  const bool split_ok = (2 * nleft <= G) && (nleft <= P4A_MAX_LEFT);
  const int bx = (int)blockIdx.x;
  int nunits = 2 * nfull;
  if (split_ok) { if (bx < 2 * nleft) nunits += 1; } else { if (bx < nleft) nunits += 2; }
  u16* MRG2 = (u16*)(ws + OFF_MRG2);
#pragma unroll 1
  for (int un = 0; un < nunits; un++) {
    int it, mix; bool side = false;
    if (un < 2 * nfull) { it = bx + (un >> 1) * G; mix = un & 1; }
    else if (split_ok) { it = nfull * G + (bx >> 1); mix = bx & 1; side = (mix == 1); }
    else { it = nfull * G + bx; mix = un & 1; }
    const bool add = (mix == 1) && !side;
    const int nt = it & 7, mt = it >> 3;
    const int m0 = mt * 128, n0 = nt * 128;
    unsigned sg[2][2][8];
    f32x16 acc[2][2];
    {
      zero_acc(acc);
      LoadBf16 lh{H + (size_t)m0 * 1024, 1024};
      gemm_mainloop(acc, lh, WTIN + (size_t)(4096 + mix * 1024 + n0) * 1024, 1024, 1024, smem);
#pragma unroll
      for (int i = 0; i < 2; i++)
#pragma unroll
        for (int j = 0; j < 2; j++)
#pragma unroll
          for (int e = 0; e < 8; e++) sg[i][j][e] = pack2(sigmoidf_(acc[i][j][2 * e]), sigmoidf_(acc[i][j][2 * e + 1]));
      zero_acc(acc);
      float* rstdL = (float*)(smem + 139264);
      {
        const float* sq = (const float*)(ws + OFF_SSQO) + ((size_t)mix * NT + m0) * 16;
        const float4 s0 = *(const float4*)(sq + tid * 8), s1 = *(const float4*)(sq + tid * 8 + 4);
        rstdL[tid * 2] = rsqrtf((s0.x + s0.y + s0.z + s0.w) * (1.f / 128.f) + EPSF);
        rstdL[tid * 2 + 1] = rsqrtf((s1.x + s1.y + s1.z + s1.w) * (1.f / 128.f) + EPSF);
      }
      LoadNormO lo{(const u16*)(ws + OFF_O) + ((size_t)mix * NT + m0) * 512,
                   (const u16*)(ws + (mix ? OFF_ZB : OFF_OGA)) + (size_t)m0 * 512,
                   rstdL, gnL + mix * 128};
      gemm_mainloop(acc, lo, (const u16*)(ws + (mix ? OFF_WT_BRB : OFF_WT_BRA)) + (size_t)n0 * 512, 512, 512, smem);
      {
        u16* T = (u16*)smem;
#pragma unroll
        for (int i = 0; i < 2; i++)
#pragma unroll
          for (int j = 0; j < 2; j++)
#pragma unroll
            for (int e = 0; e < 16; e++) {
              const float g0 = (e & 1) ? bfhi(sg[i][j][e >> 1]) : bflo(sg[i][j][e >> 1]);
              T[(wm * 64 + i * 32 + rowmap(e, lane)) * 136 + wn * 64 + j * 32 + (lane & 31)] = f2bf(g0 * acc[i][j][e]);
            }
        __syncthreads();
        u16* dbase = side ? MRG2 + (size_t)(it - nfull * G) * 16384 : MRG + (size_t)m0 * 1024 + n0;
        const int dld = side ? 128 : 1024;
#pragma unroll
        for (int q = 0; q < 8; q++) {
          const int idx = tid + 256 * q, row = idx >> 4, c8 = idx & 15;
          uint4 v4 = *(const uint4*)&T[row * 136 + c8 * 8];
          u16* mp = dbase + (size_t)row * dld + c8 * 8;
          if (add) {
            const uint4 o4 = *(const uint4*)mp;
            v4.x = pack2(bflo(v4.x) + bflo(o4.x), bfhi(v4.x) + bfhi(o4.x));
            v4.y = pack2(bflo(v4.y) + bflo(o4.y), bfhi(v4.y) + bfhi(o4.y));
            v4.z = pack2(bflo(v4.z) + bflo(o4.z), bfhi(v4.z) + bfhi(o4.z));
            v4.w = pack2(bflo(v4.w) + bflo(o4.w), bfhi(v4.w) + bfhi(o4.w));
          }
          *(uint4*)mp = v4;
        }
      }
    }
  }
  {
    const int extra = split_ok ? 2 * nleft : nleft;
    int first = bx - extra, stride = G - extra;
    if (stride <= 0) { first = bx; stride = G; }
    if (first >= 0) {
#pragma unroll 1
      for (int ci = first; ci < NCONV; ci += stride) {
        if (ci < 2048) convert_item_fp8(p.expert_u, (unsigned char*)(ws + OFF_EU), ci, EU_SCALE);
        else convert_item_fp8(p.expert_v, (unsigned char*)(ws + OFF_EV), ci - 2048, EV_SCALE);
      }
    }
  }
}

__device__ __forceinline__ void phase4a_fixup(const Params& p) {
  const int tid = threadIdx.x;
  char* ws = p.ws;
  const int NG = 132 * 8, G = (int)gridDim.x;
  const int nfull = NG / G, nleft = NG - nfull * G;
  const bool split_ok = (2 * nleft <= G) && (nleft <= P4A_MAX_LEFT);
  if (!split_ok || (int)blockIdx.x >= nleft) return;
  const int it = nfull * G + (int)blockIdx.x;
  const int nt = it & 7, mt = it >> 3;
  u16* MRG = (u16*)(ws + OFF_MRG) + (size_t)mt * 128 * 1024 + nt * 128;
  const u16* MRG2 = (const u16*)(ws + OFF_MRG2) + (size_t)blockIdx.x * 16384;
#pragma unroll
  for (int q = 0; q < 8; q++) {
    const int idx = tid + 256 * q, row = idx >> 4, c8 = idx & 15;
    u16* mp = MRG + (size_t)row * 1024 + c8 * 8;
    uint4 v4 = *(const uint4*)mp;
    const uint4 o4 = *(const uint4*)(MRG2 + row * 128 + c8 * 8);
    v4.x = pack2(bflo(v4.x) + bflo(o4.x), bfhi(v4.x) + bfhi(o4.x));
    v4.y = pack2(bflo(v4.y) + bflo(o4.y), bfhi(v4.y) + bfhi(o4.y));
    v4.z = pack2(bflo(v4.z) + bflo(o4.z), bfhi(v4.z) + bfhi(o4.z));
    v4.w = pack2(bflo(v4.w) + bflo(o4.w), bfhi(v4.w) + bfhi(o4.w));
    *(uint4*)mp = v4;
  }
}

__device__ __forceinline__ void phase4b(const Params& p, char* smem) {
  const int tid = threadIdx.x, lane = tid & 63, w = tid >> 6, wm = w >> 1, wn = w & 1;
  char* ws = p.ws;
  const u16* MRG = (const u16*)(ws + OFF_MRG);
  float* X1 = p.out + OUT_Y;
  float* SSQ1 = (float*)(ws + OFF_SSQ1);
  for (int it = blockIdx.x; it < 132 * 8; it += gridDim.x) {
    const int nt = it & 7, mt = it >> 3;
    const int m0 = mt * 128, n0 = nt * 128;
    f32x16 acc[2][2]; zero_acc(acc);
    LoadBf16 al{MRG + (size_t)m0 * 1024, 1024};
    gemm_mainloop(acc, al, (const u16*)(ws + OFF_WT_OUT) + (size_t)n0 * 1024, 1024, 1024, smem);
#pragma unroll
    for (int i = 0; i < 2; i++)
#pragma unroll
      for (int e = 0; e < 16; e++) {
        const int row = m0 + wm * 64 + i * 32 + rowmap(e, lane);
        const float* xr = xrow(p, row);
        float sq = 0.f;
#pragma unroll
        for (int j = 0; j < 2; j++) {
          const int col = n0 + wn * 64 + j * 32 + (lane & 31);
          float v = acc[i][j][e] + xr[col];
          X1[(size_t)row * 1024 + col] = v;
          ((u16*)smem)[(row - m0) * 136 + (col - n0)] = f2bf(v);
          sq += v * v;
        }
        sq = sum32(sq);
        if ((lane & 31) == 0) atomicAdd(&SSQ1[row], sq);
      }
    {
      const u16* T = (const u16*)smem;
      u16* X1B = (u16*)(ws + OFF_X1B);
      __syncthreads();
#pragma unroll
      for (int q = 0; q < 8; q++) {
        const int idx = tid + 256 * q, row = idx >> 4, c8 = idx & 15;
        *(uint4*)(X1B + (size_t)(m0 + row) * 1024 + n0 + c8 * 8) = *(const uint4*)&T[row * 136 + c8 * 8];
      }
    }
  }
}

__device__ __forceinline__ void phase4c(const Params& p, char* smem) {
  const int tid = threadIdx.x, lane = tid & 63, w = tid >> 6, wm = w >> 1, wn = w & 1;
  char* ws = p.ws;
  const float* X1 = p.out + OUT_Y;
  const float* SSQ1 = (const float*)(ws + OFF_SSQ1);
  u16* H2 = (u16*)(ws + OFF_H2);
  float* TOPS = (float*)(ws + OFF_TOPS); int* TOPI = (int*)(ws + OFF_TOPI);
  const u16* KEYS = (const u16*)(ws + OFF_KEYS);
  for (int it = blockIdx.x; it < 132 * 16; it += gridDim.x) {
    const int nt = it & 15, mt = it >> 4;
    const int m0 = mt * 128, n0 = nt * 128;
    f32x16 acc[2][2]; zero_acc(acc);
    gemm_mainloop_dma(acc, (const u16*)(ws + OFF_X1B) + (size_t)m0 * 1024, 1024, (const u16*)(ws + OFF_WT_Q) + (size_t)n0 * 1024, 1024, 1024, smem);
    u16* Aq = (u16*)smem;
    u16* Bk = Aq + 128 * 136;
    const int r = lane & 31, hh = (lane >> 5) * 8;
#pragma unroll
    for (int i = 0; i < 2; i++)
#pragma unroll
      for (int j = 0; j < 2; j++)
#pragma unroll
        for (int e = 0; e < 16; e++) {
          const int rl = wm * 64 + i * 32 + rowmap(e, lane);
          const float rs = rsqrtf(SSQ1[m0 + rl] * (1.f / 1024.f) + EPSF);
          Aq[rl * 136 + wn * 64 + j * 32 + r] = f2bf(acc[i][j][e] * rs);
        }
#pragma unroll
    for (int q = 0; q < 8; q++) {
      int idx = tid + 256 * q; int row = idx >> 4, ch = idx & 15;
      *(uint4*)&Bk[row * 136 + ch * 8] = *(const uint4*)(KEYS + ((size_t)nt * 128 + row) * 128 + ch * 8);
    }
    __syncthreads();
    zero_acc(acc);
#pragma unroll
    for (int ks = 0; ks < 8; ks++) {
      bf16x8 a[2], bq[2];
#pragma unroll
      for (int i = 0; i < 2; i++) a[i] = *(const bf16x8*)&Aq[(wm * 64 + i * 32 + r) * 136 + ks * 16 + hh];
#pragma unroll
      for (int j = 0; j < 2; j++) bq[j] = *(const bf16x8*)&Bk[(wn * 64 + j * 32 + r) * 136 + ks * 16 + hh];
#pragma unroll
      for (int i = 0; i < 2; i++)
#pragma unroll
        for (int j = 0; j < 2; j++) acc[i][j] = mfma16(a[i], bq[j], acc[i][j]);
    }
    __syncthreads();
    float* SC = (float*)smem;
#pragma unroll
    for (int i = 0; i < 2; i++)
#pragma unroll
      for (int j = 0; j < 2; j++)
#pragma unroll
        for (int e = 0; e < 16; e++) SC[(wm * 64 + i * 32 + rowmap(e, lane)) * 132 + wn * 64 + j * 32 + r] = acc[i][j][e];
    __syncthreads();
    {
      const int tokl = tid >> 1, part = tid & 1;
      float sv[64];
#pragma unroll
      for (int i = 0; i < 16; i++) {
        float4 x = *(const float4*)&SC[tokl * 132 + part * 64 + i * 4];
        const unsigned ib = 127u - (unsigned)(part * 64 + i * 4);
        sv[4 * i]     = __uint_as_float((__float_as_uint(x.x) & ~127u) | ib);
        sv[4 * i + 1] = __uint_as_float((__float_as_uint(x.y) & ~127u) | (ib - 1u));
        sv[4 * i + 2] = __uint_as_float((__float_as_uint(x.z) & ~127u) | (ib - 2u));
        sv[4 * i + 3] = __uint_as_float((__float_as_uint(x.w) & ~127u) | (ib - 3u));
      }
#define CE_DESC(a, b) { const float hi_ = fmaxf(a, b), lo_ = fminf(a, b); a = hi_; b = lo_; }
#pragma unroll
      for (int g = 0; g < 4; g++) {
#pragma unroll
        for (int lk = 1; lk <= 4; lk++) {
#pragma unroll
          for (int lj = lk - 1; lj >= 0; lj--) {
#pragma unroll
            for (int i = 0; i < 16; i++) {
              const int l = i ^ (1 << lj);
              if (l > i) {
                if ((i & (1 << lk)) == 0) { CE_DESC(sv[g * 16 + i], sv[g * 16 + l]) } else { CE_DESC(sv[g * 16 + l], sv[g * 16 + i]) }
              }
            }
          }
        }
      }
#define MERGE16(A0, B0)                                                                             \
      {                                                                                             \
        _Pragma("unroll") for (int i = 0; i < 16; i++) sv[(A0) + i] = fmaxf(sv[(A0) + i], sv[(B0) + 15 - i]); \
        _Pragma("unroll") for (int lj = 3; lj >= 0; lj--) {                                         \
          _Pragma("unroll") for (int i = 0; i < 16; i++) {                                          \
            const int l = i ^ (1 << lj);                                                            \
            if (l > i) { CE_DESC(sv[(A0) + i], sv[(A0) + l]) }                                      \
          }                                                                                         \
        }                                                                                           \
      }
      MERGE16(0, 16)
      MERGE16(32, 48)
      MERGE16(0, 32)
#pragma unroll
      for (int i = 0; i < 16; i++) sv[16 + i] = DPP_F(sv[i], 0xB1);
      MERGE16(0, 16)
      if (part == 0) {
        const size_t ob = ((size_t)(m0 + tokl) * 16 + nt) * 16;
#pragma unroll
        for (int q = 0; q < 4; q++) {
          *(float4*)(TOPS + ob + q * 4) = make_float4(sv[4 * q], sv[4 * q + 1], sv[4 * q + 2], sv[4 * q + 3]);
          *(int4*)(TOPI + ob + q * 4) = make_int4(127 - (int)(__float_as_uint(sv[4 * q]) & 127u), 127 - (int)(__float_as_uint(sv[4 * q + 1]) & 127u),
                                                  127 - (int)(__float_as_uint(sv[4 * q + 2]) & 127u), 127 - (int)(__float_as_uint(sv[4 * q + 3]) & 127u));
        }
      }
    }
  }
}

__device__ __forceinline__ float gelu_tanh(float x) {
  float u = 0.7978845608028654f * (x + 0.044715f * x * x * x);
  return 0.5f * x * (1.f + tanhf(u));
}
__device__ const unsigned char cand_tab[56] = {
  0x00,0x01,0x02,0x03,0x04,0x05,0x06,0x07,0x08,0x09,0x0a,0x0b,0x0c,0x0d,0x0e,0x0f,
  0x10,0x11,0x12,0x13,0x14,0x15,0x16,0x17,
  0x20,0x21,0x22,0x23,0x24,
  0x30,0x31,0x32,0x33,
  0x40,0x41,0x42,
  0x50,0x51, 0x60,0x61, 0x70,0x71,
  0x80,0x90,0xa0,0xb0,0xc0,0xd0,0xe0,0xf0,
  0,0,0,0,0,0};

#define P5_LOAD(A, TAB, j0)                                                                \
  _Pragma("unroll") for (int q = 0; q < 16; q++) {                                         \
    A[q] = ((const uint4*)((TAB) + (size_t)widx[(j0) + q] * 1024))[lane];                  \
  }
#define P5_FMA2(acc_, d_, i_)                                                              \
  acc_ = __builtin_elementwise_fma(__builtin_amdgcn_cvt_pk_f32_fp8((int)(d_), false), h2[2 * (i_)], acc_); \
  acc_ = __builtin_elementwise_fma(__builtin_amdgcn_cvt_pk_f32_fp8((int)(d_), true), h2[2 * (i_) + 1], acc_);
#define P5_COMPUTE_U(A, j0)                                                                                 \
  {                                                                                                         \
    float d_[16];                                                                                           \
    _Pragma("unroll") for (int q = 0; q < 16; q++) {                                                        \
      float2v ac_ = {0.f, 0.f};                                                                             \
      P5_FMA2(ac_, A[q].x, 0) P5_FMA2(ac_, A[q].y, 1) P5_FMA2(ac_, A[q].z, 2) P5_FMA2(ac_, A[q].w, 3)       \
      d_[q] = ac_.x + ac_.y;                                                                                \
    }                                                                                                       \
    _Pragma("unroll") for (int i = 0; i < 8; i++) { bool hi_ = lane & 32; float sd = hi_ ? d_[i] : d_[i + 8]; float kp = hi_ ? d_[i + 8] : d_[i]; d_[i] = kp + __shfl_xor(sd, 32); } \
    _Pragma("unroll") for (int i = 0; i < 4; i++) { bool hi_ = lane & 16; float sd = hi_ ? d_[i] : d_[i + 4]; float kp = hi_ ? d_[i + 4] : d_[i]; d_[i] = kp + __shfl_xor(sd, 16); } \
    _Pragma("unroll") for (int i = 0; i < 2; i++) { bool hi_ = lane & 8; float sd = hi_ ? d_[i] : d_[i + 2]; float kp = hi_ ? d_[i + 2] : d_[i]; d_[i] = kp + __shfl_xor(sd, 8); }   \
    { bool hi_ = lane & 4; float sd = hi_ ? d_[0] : d_[1]; float kp = hi_ ? d_[1] : d_[0]; d_[0] = kp + __shfl_xor(sd, 4); }   \
    float a_ = d_[0];                                                                                       \
    a_ += DPP_F(a_, 0x4E); a_ += DPP_F(a_, 0xB1);                                                           \
    if ((lane & 3) == 0) { const int j_ = (j0) + (lane >> 2); wwt[j_] = wgate[j_] * gelu_tanh(a_ * (1.f / EU_SCALE)) * (1.f / EV_SCALE); } \
  }
#define P5_ACC2(d_, i_, w2_)                                                               \
  o2[2 * (i_)] = __builtin_elementwise_fma(__builtin_amdgcn_cvt_pk_f32_fp8((int)(d_), false), w2_, o2[2 * (i_)]); \
  o2[2 * (i_) + 1] = __builtin_elementwise_fma(__builtin_amdgcn_cvt_pk_f32_fp8((int)(d_), true), w2_, o2[2 * (i_) + 1]);
#define P5_COMPUTE_V(A, j0)                                                                                 \
  _Pragma("unroll") for (int q = 0; q < 16; q++) {                                                          \
    const float wt = wwt[(j0) + q];                                                                         \
    const float2v w2_ = {wt, wt};                                                                           \
    P5_ACC2(A[q].x, 0, w2_) P5_ACC2(A[q].y, 1, w2_) P5_ACC2(A[q].z, 2, w2_) P5_ACC2(A[q].w, 3, w2_)         \
  }

__device__ __forceinline__ void phase5(const Params& p, char* smem, const bool store_x = true) {
  const int tid = threadIdx.x, lane = tid & 63, w = tid >> 6;
  char* ws = p.ws;
  int* widx = (int*)(smem + w * 4096);
  float* wgate = (float*)(smem + w * 4096 + 512);
  float* wwt = (float*)(smem + w * 4096 + 1024);
  int* wcnt = (int*)(smem + w * 4096 + 1536);
  float* tsL = (float*)(smem + w * 4096 + 2048);
  int* tiL = (int*)(smem + w * 4096 + 3072);
  unsigned char* ctab = (unsigned char*)(smem + 16384);
  const float* TOPS = (const float*)(ws + OFF_TOPS); const int* TOPI = (const int*)(ws + OFF_TOPI);
  const u16* H2 = (const u16*)(ws + OFF_H2);
  const unsigned char* EU = (const unsigned char*)(ws + OFF_EU); const unsigned char* EV = (const unsigned char*)(ws + OFF_EV);
  float* X = p.out + OUT_Y;
  u16* H3 = (u16*)(ws + OFF_H3);
  __syncthreads();
  if (tid < 56) ctab[tid] = cand_tab[tid];
  __syncthreads();
  uint4 pf_ts, pf_ti, pf_ha, pf_hb; float pf_ss = 1.f;
  const u16* X1B = (const u16*)(ws + OFF_X1B);
  const float* SSQ1 = (const float*)(ws + OFF_SSQ1);
  float2v gf[8];
#pragma unroll
  for (int i = 0; i < 4; i++) { const float4 g4 = *(const float4*)(p.g_ffn + lane * 16 + i * 4); gf[2 * i] = float2v{g4.x, g4.y}; gf[2 * i + 1] = float2v{g4.z, g4.w}; }
  {
    const int tok0 = (int)blockIdx.x * 4 + w;
    if (tok0 < NT) {
      pf_ts = ((const uint4*)(TOPS + (size_t)tok0 * 256))[lane];
      pf_ti = ((const uint4*)(TOPI + (size_t)tok0 * 256))[lane];
      pf_ha = *(const uint4*)(X1B + (size_t)tok0 * 1024 + lane * 16);
      pf_hb = *(const uint4*)(X1B + (size_t)tok0 * 1024 + lane * 16 + 8);
      pf_ss = SSQ1[tok0];
    }
  }
  for (int it = blockIdx.x; it < NT / 4; it += gridDim.x) {
    const int tok = it * 4 + w;
    float* xr = X + (size_t)tok * 1024 + lane * 16;
    const float4 xv0 = *(const float4*)(xr), xv1 = *(const float4*)(xr + 4), xv2 = *(const float4*)(xr + 8), xv3 = *(const float4*)(xr + 12);
    ((uint4*)tsL)[lane] = pf_ts;
    ((uint4*)tiL)[lane] = pf_ti;
    const uint4 cur_ha = pf_ha, cur_hb = pf_hb; const float cur_rs = rsqrtf(pf_ss * (1.f / 1024.f) + EPSF);
    {
      const int itn = it + (int)gridDim.x;
      if (itn < NT / 4) {
        const int tokn = itn * 4 + w;
        pf_ts = ((const uint4*)(TOPS + (size_t)tokn * 256))[lane];
        pf_ti = ((const uint4*)(TOPI + (size_t)tokn * 256))[lane];
        pf_ha = *(const uint4*)(X1B + (size_t)tokn * 1024 + lane * 16);
        pf_hb = *(const uint4*)(X1B + (size_t)tokn * 1024 + lane * 16 + 8);
        pf_ss = SSQ1[tokn];
      }
    }
    {
      const int hd = lane >> 3, g = lane & 7;
      const float* ts = tsL + hd * 32;
      const int* ti = tiL + hd * 32;
      float key[7]; int ij[7];
#pragma unroll
      for (int sl = 0; sl < 7; sl++) {
        const int cid = g * 7 + sl;
        const int t = ctab[cid];
        ij[sl] = t;
        float sum = ts[t >> 4] + ts[16 + (t & 15)];
        unsigned k = (__float_as_uint(sum) & ~63u) | (unsigned)cid;
        key[sl] = cid < 50 ? __uint_as_float(k) : NINF;
      }
      if (lane < 8) wcnt[lane] = 0;
      float m = 3.0e38f, m1 = 0.f;
#pragma unroll 1
      for (int rd = 0; rd < 16; rd++) {
        float loc = NINF;
#pragma unroll
        for (int sl = 0; sl < 7; sl++) loc = fmaxf(loc, key[sl] < m ? key[sl] : NINF);
        loc = fmaxf(loc, DPP_F(loc, 0xB1)); loc = fmaxf(loc, DPP_F(loc, 0x4E)); loc = fmaxf(loc, DPP_F(loc, 0x141));
        if (rd == 0) m1 = loc;
        m = loc;
      }
      float ev[7]; float es = 0.f;
#pragma unroll
      for (int sl = 0; sl < 7; sl++) { ev[sl] = key[sl] >= m ? __expf(key[sl] - m1) : 0.f; es += ev[sl]; }
      es += DPP_F(es, 0xB1); es += DPP_F(es, 0x4E); es += DPP_F(es, 0x141);
      const float inv = 1.f / es;
#pragma unroll
      for (int sl = 0; sl < 7; sl++) {
        if (key[sl] >= m) {
          int pos = atomicAdd(&wcnt[hd], 1);
          int ia = ti[ij[sl] >> 4], ib = ti[16 + (ij[sl] & 15)];
          widx[hd * 16 + pos] = ia * 128 + ib;
          wgate[hd * 16 + pos] = ev[sl] * inv;
        }
      }
    }
    float2v h2[8];
    {
      const uint4 a = cur_ha;
      const uint4 b2 = cur_hb;
      h2[0] = float2v{bflo(a.x), bfhi(a.x)}; h2[1] = float2v{bflo(a.y), bfhi(a.y)}; h2[2] = float2v{bflo(a.z), bfhi(a.z)}; h2[3] = float2v{bflo(a.w), bfhi(a.w)};
      h2[4] = float2v{bflo(b2.x), bfhi(b2.x)}; h2[5] = float2v{bflo(b2.y), bfhi(b2.y)}; h2[6] = float2v{bflo(b2.z), bfhi(b2.z)}; h2[7] = float2v{bflo(b2.w), bfhi(b2.w)};
#pragma unroll
      for (int i = 0; i < 8; i++) h2[i] = h2[i] * gf[i] * cur_rs;
    }
    uint4 A0[16], A1[16];
    P5_LOAD(A0, EU, 0)
#pragma unroll 1
    for (int j0 = 0; j0 < 128; j0 += 32) {
      P5_LOAD(A1, EU, j0 + 16)
      P5_COMPUTE_U(A0, j0)
      if (j0 + 32 < 128) { P5_LOAD(A0, EU, j0 + 32) } else { P5_LOAD(A0, EV, 0) }
      P5_COMPUTE_U(A1, j0 + 16)
    }
    float2v o2[8];
#pragma unroll
    for (int i = 0; i < 8; i++) o2[i] = float2v{0.f, 0.f};
#pragma unroll 1
    for (int j0 = 0; j0 < 128; j0 += 32) {
      P5_LOAD(A1, EV, j0 + 16)
      P5_COMPUTE_V(A0, j0)
      if (j0 + 32 < 128) { P5_LOAD(A0, EV, j0 + 32) }
      P5_COMPUTE_V(A1, j0 + 16)
    }
    float x2[16];
#pragma unroll
    for (int i = 0; i < 4; i++) {
      const float4 xv = i == 0 ? xv0 : i == 1 ? xv1 : i == 2 ? xv2 : xv3;
      x2[4 * i] = xv.x + o2[2 * i].x; x2[4 * i + 1] = xv.y + o2[2 * i].y; x2[4 * i + 2] = xv.z + o2[2 * i + 1].x; x2[4 * i + 3] = xv.w + o2[2 * i + 1].y;
    }
    float ss = 0.f;
#pragma unroll
    for (int i = 0; i < 16; i++) ss += x2[i] * x2[i];
    ss = wsum(ss);
    const float rs = rsqrtf(ss * (1.f / 1024.f) + EPSF);
    if (store_x) {
#pragma unroll
      for (int i = 0; i < 4; i++) *(float4*)(xr + i * 4) = make_float4(x2[4 * i], x2[4 * i + 1], x2[4 * i + 2], x2[4 * i + 3]);
    }
    unsigned hp[8];
#pragma unroll
    for (int i = 0; i < 4; i++) {
      const float4 g = *(const float4*)(p.g_ple + lane * 16 + i * 4);
      hp[2 * i] = pack2(x2[4 * i] * rs * g.x, x2[4 * i + 1] * rs * g.y);
      hp[2 * i + 1] = pack2(x2[4 * i + 2] * rs * g.z, x2[4 * i + 3] * rs * g.w);
    }
    *(uint4*)(H3 + (size_t)tok * 1024 + lane * 16) = make_uint4(hp[0], hp[1], hp[2], hp[3]);
    *(uint4*)(H3 + (size_t)tok * 1024 + lane * 16 + 8) = make_uint4(hp[4], hp[5], hp[6], hp[7]);
  }
}

__device__ __forceinline__ void phase6(const Params& p, char* smem) {
  const int tid = threadIdx.x, lane = tid & 63, w = tid >> 6, wm = w >> 1, wn = w & 1;
  char* ws = p.ws;
  const u16* H3 = (const u16*)(ws + OFF_H3);
  float* X = p.out + OUT_Y;
  float* SSQ3 = (float*)(ws + OFF_SSQ3);
  for (int it = blockIdx.x; it < 132 * 8; it += gridDim.x) {
    const int nt = it & 7, mt = it >> 3;
    const int m0 = mt * 128, n0 = nt * 128;
    f32x16 acc1[2][2]; zero_acc(acc1);
    unsigned pe[2][2][8];
    {
      LoadF32 lp{m0 < NTP ? p.p_prompt + (size_t)m0 * 256 : p.p_sample + (size_t)(m0 - NTP) * 256, 256};
      gemm_mainloop(acc1, lp, (const u16*)(ws + OFF_WT_PLE) + (size_t)n0 * 256, 256, 256, smem);
#pragma unroll
      for (int i = 0; i < 2; i++)
#pragma unroll
        for (int j = 0; j < 2; j++)
#pragma unroll
          for (int e = 0; e < 8; e++) pe[i][j][e] = pack2(acc1[i][j][2 * e], acc1[i][j][2 * e + 1]);
      zero_acc(acc1);
    }
    LoadBf16 al{H3 + (size_t)m0 * 1024, 1024};
    gemm_mainloop(acc1, al, (const u16*)(ws + OFF_WT_PG) + (size_t)n0 * 1024, 1024, 1024, smem);
#pragma unroll
    for (int i = 0; i < 2; i++)
#pragma unroll
      for (int e = 0; e < 16; e++) {
        const int row = m0 + wm * 64 + i * 32 + rowmap(e, lane);
        float sq = 0.f;
#pragma unroll
        for (int j = 0; j < 2; j++) {
          const int col = n0 + wn * 64 + j * 32 + (lane & 31);
          float* xp = X + (size_t)row * 1024 + col;
          float v = *xp + ((e & 1) ? bfhi(pe[i][j][e >> 1]) : bflo(pe[i][j][e >> 1])) * sigmoidf_(acc1[i][j][e]);
          *xp = v;
          sq += v * v;
        }
        sq = sum32(sq);
        if ((lane & 31) == 0) atomicAdd(&SSQ3[row], sq);
      }
  }
}

__device__ __forceinline__ void phase7(const Params& p) {
  const int tid = threadIdx.x;
  float* X = p.out + OUT_Y;
  const float* SSQ3 = (const float*)(p.ws + OFF_SSQ3);
  for (int it = blockIdx.x; it < NT / 2; it += gridDim.x) {
    const size_t base = (size_t)it * 2048 + (size_t)tid * 8;
    const int row = (int)(base >> 10), k = (int)(base & 1023);
    const float rs = rsqrtf(SSQ3[row] * (1.f / 1024.f) + EPSF);
    float4 a = *(const float4*)(X + base), b = *(const float4*)(X + base + 4);
    float4 g0 = *(const float4*)(p.g_final + k), g1 = *(const float4*)(p.g_final + k + 4);
    nt_store4(X + base, a.x * rs * g0.x, a.y * rs * g0.y, a.z * rs * g0.z, a.w * rs * g0.w);
    nt_store4(X + base + 4, b.x * rs * g1.x, b.y * rs * g1.y, b.z * rs * g1.z, b.w * rs * g1.w);
  }
}

#define XB_TMO      128
#define XB_XCNT(j)  (256  + 64 * (j))
#define XB_XSUB(j)  (1280 + 64 * (j))
#define XB_XGEN(j)  (2304 + 64 * (j))
#define XB_TOP      3328
#define XB_TOPGEN   3392
#define XCD_BAR_WORDS 3456
#define XB_SPIN_CAP (1u << 22)
#define LAS __attribute__((address_space(3)))
__device__ __forceinline__ unsigned xb_ld(unsigned* p)              { return __hip_atomic_load(p, __ATOMIC_RELAXED, __HIP_MEMORY_SCOPE_AGENT); }
__device__ __forceinline__ unsigned xb_add(unsigned* p, unsigned v) { return __hip_atomic_fetch_add(p, v, __ATOMIC_RELAXED, __HIP_MEMORY_SCOPE_AGENT); }
__device__ __forceinline__ unsigned xb_xcc_id() { return (unsigned)__builtin_amdgcn_s_getreg((3 << 11) | 20) & 0xFu; }
#define XB_SPIN(cond, bar) do { unsigned _sp = 0; while (cond) { __builtin_amdgcn_s_sleep(1); \
    if ((++_sp & 255u) == 0u) { if (xb_ld(&(bar)[XB_TMO])) break; if (_sp > XB_SPIN_CAP) { atomicAdd(&(bar)[XB_TMO], 1u); break; } } } } while (0)
struct XcdBarrier { unsigned* bar; unsigned x; volatile LAS unsigned* st; };
__device__ __forceinline__ XcdBarrier xcd_barrier_post(unsigned* bar, volatile LAS unsigned* st) {
    XcdBarrier b; b.bar = bar; b.x = xb_xcc_id(); b.st = st;
    if (threadIdx.x == 0) (void)xb_add(&bar[XB_XCNT(b.x)], 1u);
    return b;
}
__device__ __forceinline__ void xcd_barrier_complete(unsigned* bar, unsigned x, unsigned& nloc, unsigned& nx) {
    const unsigned G = gridDim.x * gridDim.y * gridDim.z;
    unsigned sum, cnt, mine, sp = 0u;
    for (;;) {
        sum = 0u; cnt = 0u; mine = 0u;
#pragma unroll
        for (unsigned j = 0; j < 16; ++j) { const unsigned c = xb_ld(&bar[XB_XCNT(j)]); sum += c; cnt += (c > 0u) ? 1u : 0u; mine = (j == x) ? c : mine; }
        if (sum == G) break;
        __builtin_amdgcn_s_sleep(1);
        if ((++sp & 255u) == 0u) { if (xb_ld(&bar[XB_TMO])) break; if (sp > XB_SPIN_CAP) { atomicAdd(&bar[XB_TMO], 1u); break; } }
    }
    nloc = mine > 0u ? mine : 1u; nx = cnt > 0u ? cnt : 1u;
}
__device__ __forceinline__ void xcd_barrier(const XcdBarrier& b) {
    asm volatile("s_waitcnt vmcnt(0)" ::: "memory");
    __syncthreads();
    if (threadIdx.x == 0) {
        unsigned* bar = b.bar;
        __builtin_amdgcn_s_waitcnt(0);
        unsigned nloc = b.st[0], nx = b.st[1];
        if (nloc == 0u) { xcd_barrier_complete(bar, b.x, nloc, nx); b.st[0] = nloc; b.st[1] = nx; }
        const unsigned old = xb_add(&bar[XB_XSUB(b.x)], 1u);
        const unsigned gen = old / nloc;
        if (old + 1u == (gen + 1u) * nloc) {
            __builtin_amdgcn_fence(__ATOMIC_RELEASE, "agent");
            asm volatile("s_waitcnt vmcnt(0)" ::: "memory");
            const unsigned og = xb_add(&bar[XB_TOP], 1u);
            const unsigned tg = og / nx;
            if (og + 1u == (tg + 1u) * nx) xb_add(&bar[XB_TOPGEN], 1u);
            else XB_SPIN(xb_ld(&bar[XB_TOPGEN]) == tg, bar);
            __builtin_amdgcn_fence(__ATOMIC_ACQUIRE, "agent");
            xb_add(&bar[XB_XGEN(b.x)], 1u);
            asm volatile("s_waitcnt vmcnt(0)" ::: "memory");
        } else {
            XB_SPIN(xb_ld(&bar[XB_XGEN(b.x)]) == gen, bar);
            __builtin_amdgcn_fence(__ATOMIC_ACQUIRE, "agent");
            asm volatile("s_waitcnt vmcnt(0)" ::: "memory");
        }
    }
    __syncthreads();
}

__global__ void __launch_bounds__(256) mega_kernel(Params p) {
  __shared__ __attribute__((aligned(16))) char smem[SMEM_BYTES];
  cg::grid_group grid = cg::this_grid();
  __shared__ uint4 xb_words;
  if (threadIdx.x == 0) xb_words = make_uint4(0u, 0u, 0u, 0u);
  __syncthreads();
  XcdBarrier xb = xcd_barrier_post((unsigned*)(p.ws + OFF_BAR), (volatile LAS unsigned*)&xb_words);
  phase0(p, smem);
  if (p.ws == nullptr) grid.sync();
  xcd_barrier(xb);
#if PROBE == 9
  for (int i = 0; i < 20; i++) xcd_barrier(xb);
#endif
#if PROBE == 10
  phase0(p, smem);
  xcd_barrier(xb);
#endif
  phase1(p, smem);
  xcd_barrier(xb);
#if PROBE == 1
  phase1(p, smem);
  xcd_barrier(xb);
#endif
  phase2(p, smem);
  xcd_barrier(xb);
#if PROBE == 2
  phase2(p, smem);
  xcd_barrier(xb);
#endif
#if PROBE == 21
  phase2(p, smem, 0, 1024);
  xcd_barrier(xb);
#endif
#if PROBE == 22
  phase2(p, smem, 1024, 2048);
  xcd_barrier(xb);
#endif
#if PROBE == 23
  phase2(p, smem, 2048, 3072);
  xcd_barrier(xb);
#endif
#if PROBE == 6
  phase3(p, smem, false);
  xcd_barrier(xb);
#endif
  phase3(p, smem);
  xcd_barrier(xb);
  phase4a(p, smem);
  xcd_barrier(xb);
  phase4a_fixup(p);
  xcd_barrier(xb);
#if PROBE == 3
  phase4a(p, smem);
  xcd_barrier(xb);
#endif
  phase4b(p, smem);
  xcd_barrier(xb);
  phase4c(p, smem);
  xcd_barrier(xb);
#if PROBE == 4
  phase4c(p, smem);
  xcd_barrier(xb);
#endif
#if PROBE == 5
  phase5(p, smem, false);
  xcd_barrier(xb);
#endif
  phase5(p, smem);
  xcd_barrier(xb);
  phase6(p, smem);
  xcd_barrier(xb);
  phase7(p);
}

extern "C" void kernel_launch(void* const* d_in, const int* in_sizes, int n_in, void* d_out, int out_size,
                              void* d_ws, size_t ws_size, hipStream_t stream) {
  static int grid_blocks = 0;
  if (!grid_blocks) {
    int dev = 0, cus = 0, per_cu = 0;
    hipGetDevice(&dev);
    hipDeviceGetAttribute(&cus, hipDeviceAttributeMultiprocessorCount, dev);
    hipOccupancyMaxActiveBlocksPerMultiprocessor(&per_cu, mega_kernel, 256, 0);
    if (per_cu > 2) per_cu = 2;
    if (per_cu < 1) per_cu = 1;
    grid_blocks = cus * per_cu;
  }
  if (ws_size < WS_TOTAL) { fprintf(stderr, "workspace too small: %zu < %zu\n", ws_size, (size_t)WS_TOTAL); return; }
  Params p{};
  const float** pf = (const float**)&p;
  for (int i = 0; i < 27; i++) pf[i] = (const float*)d_in[i];
  p.out = (float*)d_out;
  p.ws = (char*)d_ws;
  hipMemsetAsync((char*)d_ws + OFF_BAR, 0, 16384, stream);
  void* args[] = {&p};
  hipError_t e = hipLaunchCooperativeKernel((void*)mega_kernel, dim3(grid_blocks), dim3(256), args, 0, stream);
  if (e != hipSuccess) fprintf(stderr, "cooperative launch failed: %s (grid %d)\n", hipGetErrorString(e), grid_blocks);
}
```

```cpp
#include <hip/hip_runtime.h>
#include <hip/hip_cooperative_groups.h>
#include <stdint.h>
#include <stdio.h>
namespace cg = cooperative_groups;

typedef unsigned short u16;
typedef __attribute__((ext_vector_type(8))) short bf16x8;
typedef __attribute__((ext_vector_type(16))) float f32x16;

#define NTP 16384
#define NTS 512
#define NT 16896
#define EPSF 1e-6f
#define NINF (-3.0e38f)

constexpr size_t OFF_WT_IN  = 0;
constexpr size_t OFF_WT_BRA = OFF_WT_IN + 12582912;
constexpr size_t OFF_WT_BRB = OFF_WT_BRA + 1048576;
constexpr size_t OFF_WT_OUT = OFF_WT_BRB + 1048576;
constexpr size_t OFF_WT_Q   = OFF_WT_OUT + 2097152;
constexpr size_t OFF_WT_PG  = OFF_WT_Q + 4194304;
constexpr size_t OFF_WT_PLE = OFF_WT_PG + 2097152;
constexpr size_t OFF_KEYS   = OFF_WT_PLE + 524288;
constexpr size_t OFF_H      = OFF_KEYS + 524288;
constexpr size_t OFF_BETA   = OFF_H + 34603008;
constexpr size_t OFF_GLOG   = OFF_BETA + 270336;
constexpr size_t OFF_DVEC   = OFF_GLOG + 270336;
constexpr size_t OFF_SSQO   = OFF_DVEC + 1048576;
constexpr size_t OFF_SSQ1   = OFF_SSQO + 2162688;
constexpr size_t OFF_SSQ3   = OFF_SSQ1 + 67584;
constexpr size_t OFF_R3     = OFF_SSQ3 + 67584;
constexpr size_t OFF_LOGF   = OFF_R3;
constexpr size_t OFF_VA     = OFF_R3 + 34603008;
constexpr size_t OFF_MRG    = OFF_R3;
constexpr size_t OFF_H2     = OFF_R3;
constexpr size_t OFF_R4     = OFF_R3 + 51904512;
constexpr size_t OFF_OGA    = OFF_R4;
constexpr size_t OFF_ZB     = OFF_R4 + 17301504;
constexpr size_t OFF_TOPS   = OFF_R4;
constexpr size_t OFF_TOPI   = OFF_R4 + 17301504;
constexpr size_t OFF_R5     = OFF_R4 + 34603008;
constexpr size_t OFF_O      = OFF_R5;
constexpr size_t OFF_H3     = OFF_R5;
constexpr size_t OFF_X1B    = OFF_R5;
constexpr size_t OFF_R6     = OFF_R5 + 34603008;
constexpr size_t OFF_QB     = OFF_R6;
constexpr size_t OFF_KT     = OFF_R6 + 33554432;
constexpr size_t OFF_VT     = OFF_R6 + 67108864;
constexpr size_t OFF_PN     = OFF_R6 + 100663296;
constexpr size_t OFF_EU     = OFF_R6;
constexpr size_t OFF_EV     = OFF_R6 + 16777216;
constexpr size_t OFF_BAR    = OFF_R6 + 134217728;
constexpr size_t OFF_MRG2   = OFF_BAR + 16384;
#define P4A_MAX_LEFT 64
constexpr size_t WS_TOTAL   = OFF_MRG2 + 64 * 32768;
static_assert(WS_TOTAL <= 330000000, "ws too big");

constexpr size_t OUT_Y   = 0;
constexpr size_t OUT_HP  = 17301504;
constexpr size_t OUT_DP  = 17825792;
constexpr size_t OUT_CP  = 18350080;
constexpr size_t OUT_HS  = 18386944;
constexpr size_t OUT_DS  = 26775552;
constexpr size_t OUT_CS  = 35164160;
constexpr size_t OUTB_RAW = 0;
constexpr size_t OUTB_QA  = 51904512;

struct Params {
  const float *x_prompt, *x_sample, *state_hgrn, *state_delta, *state_conv, *p_prompt, *p_sample,
      *lb_param, *g_mix, *w_in, *conv_w, *a_log, *dt_bias, *g_norm_a, *g_norm_b, *w_br_a, *w_br_b,
      *w_out, *g_ffn, *peer_wq, *peer_keys, *expert_u, *expert_v, *g_ple, *w_ple, *w_ple_gate, *g_final;
  float* out;
  char* ws;
};

#define SMEM_BYTES 145408
#ifndef PROBE
#define PROBE 0
#endif

typedef float f32x2_t __attribute__((ext_vector_type(2)));
typedef __bf16 bf16x2_t __attribute__((ext_vector_type(2)));
__device__ __forceinline__ unsigned pack2(float a, float b) {
  f32x2_t f = {a, b};
  bf16x2_t h = __builtin_convertvector(f, bf16x2_t);
  return __builtin_bit_cast(unsigned, h);
}
__device__ __forceinline__ u16 f2bf(float f) { return (u16)(pack2(f, f) & 0xffffu); }
__device__ __forceinline__ float bf2f(u16 h) { return __uint_as_float(((unsigned)h) << 16); }
__device__ __forceinline__ float bflo(unsigned u) { return __uint_as_float(u << 16); }
__device__ __forceinline__ float bfhi(unsigned u) { return __uint_as_float(u & 0xffff0000u); }
#define DPP_F(v, ctrl) __int_as_float(__builtin_amdgcn_update_dpp(0, __float_as_int(v), (ctrl), 0xF, 0xF, true))
__device__ __forceinline__ float dpp_row_sum16(float v) {
  v += __int_as_float(__builtin_amdgcn_update_dpp(0, __float_as_int(v), 0xB1, 0xF, 0xF, true));
  v += __int_as_float(__builtin_amdgcn_update_dpp(0, __float_as_int(v), 0x4E, 0xF, 0xF, true));
  v += __int_as_float(__builtin_amdgcn_update_dpp(0, __float_as_int(v), 0x141, 0xF, 0xF, true));
  v += __int_as_float(__builtin_amdgcn_update_dpp(0, __float_as_int(v), 0x140, 0xF, 0xF, true));
  return v;
}
__device__ __forceinline__ float sum32(float v) { v = dpp_row_sum16(v); v += __shfl_xor(v, 16); return v; }
__device__ __forceinline__ float wsum(float v) { v = dpp_row_sum16(v); v += __shfl_xor(v, 16); v += __shfl_xor(v, 32); return v; }
__device__ __forceinline__ float sigmoidf_(float x) { return __builtin_amdgcn_rcpf(1.f + __expf(-x)); }
__device__ __forceinline__ float siluf_(float x) { return x * __builtin_amdgcn_rcpf(1.f + __expf(-x)); }
__device__ __forceinline__ int rowmap(int e, int lane) { return (e & 3) + 8 * (e >> 2) + 4 * (lane >> 5); }
__device__ __forceinline__ f32x16 mfma16(bf16x8 a, bf16x8 b, f32x16 c) {
  return __builtin_amdgcn_mfma_f32_32x32x16_bf16(a, b, c, 0, 0, 0);
}
__device__ __forceinline__ f32x16 zero16() {
  f32x16 z;
#pragma unroll
  for (int e = 0; e < 16; e++) z[e] = 0.f;
  return z;
}
__device__ __forceinline__ const float* xrow(const Params& p, int tok) {
  return tok < NTP ? p.x_prompt + (size_t)tok * 1024 : p.x_sample + (size_t)(tok - NTP) * 1024;
}

__device__ __forceinline__ float transpose_reduce64(float (&v)[64], int lane) {
#pragma unroll
  for (int i = 0; i < 32; i++) { bool hi = lane & 32; float send = hi ? v[i] : v[i + 32]; float keep = hi ? v[i + 32] : v[i]; v[i] = keep + __shfl_xor(send, 32); }
#pragma unroll
  for (int i = 0; i < 16; i++) { bool hi = lane & 16; float send = hi ? v[i] : v[i + 16]; float keep = hi ? v[i + 16] : v[i]; v[i] = keep + __shfl_xor(send, 16); }
#pragma unroll
  for (int i = 0; i < 8; i++) { bool hi = lane & 8; float send = hi ? v[i] : v[i + 8]; float keep = hi ? v[i + 8] : v[i]; v[i] = keep + __shfl_xor(send, 8); }
#pragma unroll
  for (int i = 0; i < 4; i++) { bool hi = lane & 4; float send = hi ? v[i] : v[i + 4]; float keep = hi ? v[i + 4] : v[i]; v[i] = keep + __shfl_xor(send, 4); }
#pragma unroll
  for (int i = 0; i < 2; i++) { bool hi = lane & 2; float send = hi ? v[i] : v[i + 2]; float keep = hi ? v[i + 2] : v[i]; v[i] = keep + __shfl_xor(send, 2); }
  { bool hi = lane & 1; float send = hi ? v[0] : v[1]; float keep = hi ? v[1] : v[0]; v[0] = keep + __shfl_xor(send, 1); }
  return v[0];
}

struct LoadBf16 {
  const u16* A; int lda;
  struct Raw { uint4 v; };
  __device__ __forceinline__ void load(Raw& r, int row, int k) const { r.v = *(const uint4*)(A + (size_t)row * lda + k); }
  __device__ __forceinline__ uint4 cvt(const Raw& r, int row, int k) const { return r.v; }
};
struct LoadF32 {
  const float* A; int lda;
  struct Raw { float4 a, b; };
  __device__ __forceinline__ void load(Raw& r, int row, int k) const {
    const float4* q = (const float4*)(A + (size_t)row * lda + k); r.a = q[0]; r.b = q[1];
  }
  __device__ __forceinline__ uint4 cvt(const Raw& r, int row, int k) const {
    uint4 o; o.x = pack2(r.a.x, r.a.y); o.y = pack2(r.a.z, r.a.w); o.z = pack2(r.b.x, r.b.y); o.w = pack2(r.b.z, r.b.w); return o;
  }
};
struct LoadNormO {
  const u16* O; const u16* G; const float* rstdL; const float* gn;
  struct Raw { uint4 o, g; };
  __device__ __forceinline__ void load(Raw& r, int row, int k) const {
    r.o = *(const uint4*)(O + (size_t)row * 512 + k);
    r.g = *(const uint4*)(G + (size_t)row * 512 + k);
  }
  __device__ __forceinline__ uint4 cvt(const Raw& r, int row, int k) const {
    const float rs = rstdL[row * 4 + (k >> 7)];
    const float4* gq = (const float4*)(gn + (k & 127));
    float4 g0 = gq[0], g1 = gq[1];
    uint4 o;
    o.x = pack2(bflo(r.o.x) * rs * g0.x * bflo(r.g.x), bfhi(r.o.x) * rs * g0.y * bfhi(r.g.x));
    o.y = pack2(bflo(r.o.y) * rs * g0.z * bflo(r.g.y), bfhi(r.o.y) * rs * g0.w * bfhi(r.g.y));
    o.z = pack2(bflo(r.o.z) * rs * g1.x * bflo(r.g.z), bfhi(r.o.z) * rs * g1.y * bfhi(r.g.z));
    o.w = pack2(bflo(r.o.w) * rs * g1.z * bflo(r.g.w), bfhi(r.o.w) * rs * g1.w * bfhi(r.g.w));
    return o;
  }
};
struct LoadNormX {
  const float* X; const float* SSQ; const float* g; u16* Hout;
  struct Raw { float4 a, b; float s; };
  __device__ __forceinline__ void load(Raw& r, int row, int k) const {
    const float4* q = (const float4*)(X + (size_t)row * 1024 + k); r.a = q[0]; r.b = q[1]; r.s = SSQ[row];
  }
  __device__ __forceinline__ uint4 cvt(const Raw& r, int row, int k) const {
    float rs = rsqrtf(r.s * (1.f / 1024.f) + EPSF);
    const float4* gq = (const float4*)(g + k);
    float4 g0 = gq[0], g1 = gq[1];
    uint4 o;
    o.x = pack2(r.a.x * rs * g0.x, r.a.y * rs * g0.y); o.y = pack2(r.a.z * rs * g0.z, r.a.w * rs * g0.w);
    o.z = pack2(r.b.x * rs * g1.x, r.b.y * rs * g1.y); o.w = pack2(r.b.z * rs * g1.z, r.b.w * rs * g1.w);
    if (Hout) *(uint4*)(Hout + (size_t)row * 1024 + k) = o;
    return o;
  }
};

#define GM_LOAD1(kt_, j)                                                                                           \
  al.load(ar##j, lr + 16 * j, (kt_) * 128 + lk);                                                                   \
  br##j = *(const uint4*)(Bt + (size_t)(lr + 16 * j) * ldb + (kt_) * 128 + lk);
#define GM_LOAD(kt_) { GM_LOAD1(kt_, 0) GM_LOAD1(kt_, 1) GM_LOAD1(kt_, 2) GM_LOAD1(kt_, 3) GM_LOAD1(kt_, 4) GM_LOAD1(kt_, 5) GM_LOAD1(kt_, 6) GM_LOAD1(kt_, 7) }
#define GM_STORE1(kt_, An, Bn, j)                                                                                  \
  *(uint4*)&An[(lr + 16 * j) * 136 + lk] = al.cvt(ar##j, lr + 16 * j, (kt_) * 128 + lk);                           \
  *(uint4*)&Bn[(lr + 16 * j) * 136 + lk] = br##j;
#define GM_STORE(kt_, buf_)                                                                                        \
  {                                                                                                                \
    u16* An = As + (buf_) * 128 * 136; u16* Bn = Bs + (buf_) * 128 * 136;                                          \
    GM_STORE1(kt_, An, Bn, 0) GM_STORE1(kt_, An, Bn, 1) GM_STORE1(kt_, An, Bn, 2) GM_STORE1(kt_, An, Bn, 3)        \
    GM_STORE1(kt_, An, Bn, 4) GM_STORE1(kt_, An, Bn, 5) GM_STORE1(kt_, An, Bn, 6) GM_STORE1(kt_, An, Bn, 7)        \
  }
#define GM_FRAG(FA, FB, Ac, Bc, ks)                                                                               \
  FA##0 = *(const bf16x8*)&Ac[(wm * 64 + r) * 136 + (ks) * 16 + hh];                                               \
  FA##1 = *(const bf16x8*)&Ac[(wm * 64 + 32 + r) * 136 + (ks) * 16 + hh];                                          \
  FB##0 = *(const bf16x8*)&Bc[(wn * 64 + r) * 136 + (ks) * 16 + hh];                                               \
  FB##1 = *(const bf16x8*)&Bc[(wn * 64 + 32 + r) * 136 + (ks) * 16 + hh];
#define GM_MFMA4(FA, FB)                                                                                           \
  acc[0][0] = mfma16(FA##0, FB##0, acc[0][0]); acc[0][1] = mfma16(FA##0, FB##1, acc[0][1]);                        \
  acc[1][0] = mfma16(FA##1, FB##0, acc[1][0]); acc[1][1] = mfma16(FA##1, FB##1, acc[1][1]);
#define GM_COMPUTE(buf_)                                                                                           \
  {                                                                                                                \
    const u16* Ac = As + (buf_) * 128 * 136; const u16* Bc = Bs + (buf_) * 128 * 136;                              \
    bf16x8 fa0, fa1, fb0, fb1, ga0, ga1, gb0, gb1;                                                                 \
    GM_FRAG(fa, fb, Ac, Bc, 0)                                                                                     \
    _Pragma("unroll") for (int ks = 0; ks < 8; ks += 2) {                                                          \
      GM_FRAG(ga, gb, Ac, Bc, ks + 1)                                                                              \
      __builtin_amdgcn_sched_barrier(0);                                                                           \
      GM_MFMA4(fa, fb)                                                                                             \
      __builtin_amdgcn_sched_barrier(0);                                                                           \
      if (ks + 2 < 8) { GM_FRAG(fa, fb, Ac, Bc, ks + 2) }                                                          \
      __builtin_amdgcn_sched_barrier(0);                                                                           \
      GM_MFMA4(ga, gb)                                                                                             \
      __builtin_amdgcn_sched_barrier(0);                                                                           \
    }                                                                                                              \
  }
#define GEMM_LDS_BYTES 139264
template <class AL>
__device__ __forceinline__ void gemm_mainloop(f32x16 (&acc)[2][2], const AL& al, const u16* __restrict__ Bt, int ldb, int K, char* smem) {
  const int tid = threadIdx.x, lane = tid & 63, w = tid >> 6;
  const int wm = w >> 1, wn = w & 1;
  const int lr = tid >> 4, lk = (tid & 15) * 8;
  u16* As = (u16*)smem;
  u16* Bs = As + 2 * 128 * 136;
  typename AL::Raw ar0, ar1, ar2, ar3, ar4, ar5, ar6, ar7; uint4 br0, br1, br2, br3, br4, br5, br6, br7;
  const int KT = K >> 7;
  const int r = lane & 31, hh = (lane >> 5) * 8;
  __syncthreads();
  GM_LOAD(0)
  GM_STORE(0, 0)
  __syncthreads();
#pragma unroll 1
  for (int kt = 0; kt < KT; kt += 2) {
    if (kt + 1 < KT) { GM_LOAD(kt + 1) }
    GM_COMPUTE(0)
    if (kt + 1 < KT) { GM_STORE(kt + 1, 1) }
    __syncthreads();
    if (kt + 1 < KT) {
      if (kt + 2 < KT) { GM_LOAD(kt + 2) }
      GM_COMPUTE(1)
      if (kt + 2 < KT) { GM_STORE(kt + 2, 0) }
      __syncthreads();
    }
  }
}
#define GL_DMA(kt_, buf_)                                                                                          \
  {                                                                                                                \
    char* Ab_ = smem + (buf_) * 65536; char* Bb_ = Ab_ + 32768;                                                    \
    _Pragma("unroll") for (int i = 0; i < 8; i++) {                                                                \
      const int rowb = 4 * (i * 4 + w);                                                                            \
      const int row = rowb + (lane >> 4);                                                                          \
      const int c = (lane & 15) ^ (row & 15);                                                                      \
      __builtin_amdgcn_global_load_lds((const unsigned*)(A + (size_t)row * lda + (kt_) * 128 + c * 8), (unsigned*)(Ab_ + rowb * 256), 16, 0, 0); \
      __builtin_amdgcn_global_load_lds((const unsigned*)(Bt + (size_t)row * ldb + (kt_) * 128 + c * 8), (unsigned*)(Bb_ + rowb * 256), 16, 0, 0); \
    }                                                                                                              \
  }
#define GL_FRAG(FA, FB, Ac, Bc, ks)                                                                                \
  {                                                                                                                \
    const int co_ = (((ks) * 2 + hsel) ^ swz) * 8;                                                                 \
    FA##0 = *(const bf16x8*)&Ac[(wm * 64 + r) * 128 + co_];                                                        \
    FA##1 = *(const bf16x8*)&Ac[(wm * 64 + 32 + r) * 128 + co_];                                                   \
    FB##0 = *(const bf16x8*)&Bc[(wn * 64 + r) * 128 + co_];                                                        \
    FB##1 = *(const bf16x8*)&Bc[(wn * 64 + 32 + r) * 128 + co_];                                                   \
  }
#define GL_COMPUTE(buf_)                                                                                           \
  {                                                                                                                \
    const u16* Ac = (const u16*)(smem + (buf_) * 65536); const u16* Bc = Ac + 16384;                               \
    bf16x8 fa0, fa1, fb0, fb1, ga0, ga1, gb0, gb1;                                                                 \
    GL_FRAG(fa, fb, Ac, Bc, 0)                                                                                     \
    _Pragma("unroll") for (int ks = 0; ks < 8; ks += 2) {                                                          \
      GL_FRAG(ga, gb, Ac, Bc, ks + 1)                                                                              \
      __builtin_amdgcn_sched_barrier(0);                                                                           \
      GM_MFMA4(fa, fb)                                                                                             \
      __builtin_amdgcn_sched_barrier(0);                                                                           \
      if (ks + 2 < 8) { GL_FRAG(fa, fb, Ac, Bc, ks + 2) }                                                          \
      __builtin_amdgcn_sched_barrier(0);                                                                           \
      GM_MFMA4(ga, gb)                                                                                             \
      __builtin_amdgcn_sched_barrier(0);                                                                           \
    }                                                                                                              \
  }
__device__ __forceinline__ void gemm_mainloop_dma(f32x16 (&acc)[2][2], const u16* __restrict__ A, int lda, const u16* __restrict__ Bt, int ldb, int K, char* smem) {
  const int tid = threadIdx.x, lane = tid & 63, w = tid >> 6;
  const int wm = w >> 1, wn = w & 1;
  const int KT = K >> 7;
  const int r = lane & 31, hsel = lane >> 5, swz = lane & 15;
  __syncthreads();
  GL_DMA(0, 0)
  asm volatile("s_waitcnt vmcnt(0)" ::: "memory");
  __syncthreads();
#pragma unroll 1
  for (int kt = 0; kt < KT; kt += 2) {
    if (kt + 1 < KT) { GL_DMA(kt + 1, 1) }
    GL_COMPUTE(0)
    asm volatile("s_waitcnt vmcnt(0)" ::: "memory");
    __syncthreads();
    if (kt + 1 < KT) {
      if (kt + 2 < KT) { GL_DMA(kt + 2, 0) }
      GL_COMPUTE(1)
      asm volatile("s_waitcnt vmcnt(0)" ::: "memory");
      __syncthreads();
    }
  }
}
__device__ __forceinline__ void zero_acc(f32x16 (&acc)[2][2]) {
#pragma unroll
  for (int i = 0; i < 2; i++)
#pragma unroll
    for (int j = 0; j < 2; j++) acc[i][j] = zero16();
}

__device__ __forceinline__ void transpose_tile(const float* __restrict__ src, int ldn, int K, u16* __restrict__ dst, int k0, int ns0, int nd0, char* smem, const float* __restrict__ kscale = nullptr) {
  float* t = (float*)smem;
  const int tid = threadIdx.x;
  __syncthreads();
#pragma unroll
  for (int i = 0; i < 4; i++) {
    int idx = tid + 256 * i; int rr = idx >> 4, c4 = (idx & 15) * 4;
    float4 v = *(const float4*)(src + (size_t)(k0 + rr) * ldn + ns0 + c4);
    if (kscale) { const float sc = kscale[k0 + rr]; v.x *= sc; v.y *= sc; v.z *= sc; v.w *= sc; }
    t[c4 * 65 + rr] = v.x; t[(c4 + 1) * 65 + rr] = v.y; t[(c4 + 2) * 65 + rr] = v.z; t[(c4 + 3) * 65 + rr] = v.w;
  }
  __syncthreads();
  const int n = tid >> 2, kq = (tid & 3) * 16;
  unsigned pk[8];
#pragma unroll
  for (int i = 0; i < 8; i++) pk[i] = pack2(t[n * 65 + kq + 2 * i], t[n * 65 + kq + 2 * i + 1]);
  uint4* d = (uint4*)(dst + (size_t)(nd0 + n) * K + k0 + kq);
  d[0] = make_uint4(pk[0], pk[1], pk[2], pk[3]);
  d[1] = make_uint4(pk[4], pk[5], pk[6], pk[7]);
}
__device__ __forceinline__ void convert_item4(const float* __restrict__ src, u16* __restrict__ dst, size_t item) {
  size_t base = item * 8192 + (size_t)threadIdx.x * 8;
  float4 a[4], b[4];
#pragma unroll
  for (int i = 0; i < 4; i++) { const float4* q = (const float4*)(src + base + i * 2048); a[i] = q[0]; b[i] = q[1]; }
#pragma unroll
  for (int i = 0; i < 4; i++)
    *(uint4*)(dst + base + i * 2048) = make_uint4(pack2(a[i].x, a[i].y), pack2(a[i].z, a[i].w), pack2(b[i].x, b[i].y), pack2(b[i].z, b[i].w));
}
typedef float float2v __attribute__((ext_vector_type(2)));
#define EU_SCALE 64.f
#define EV_SCALE 16.f
__device__ __forceinline__ void convert_item_fp8(const float* __restrict__ src, unsigned char* __restrict__ dst, size_t item, float scale) {
  size_t base = item * 8192 + (size_t)threadIdx.x * 16;
  float4 a[2][4];
#pragma unroll
  for (int i = 0; i < 2; i++) {
    const float4* q = (const float4*)(src + base + i * 4096);
#pragma unroll
    for (int j = 0; j < 4; j++) a[i][j] = q[j];
  }
#pragma unroll
  for (int i = 0; i < 2; i++) {
    unsigned o[4];
#pragma unroll
    for (int j = 0; j < 4; j++) {
      int pk = __builtin_amdgcn_cvt_pk_fp8_f32(a[i][j].x * scale, a[i][j].y * scale, 0, false);
      pk = __builtin_amdgcn_cvt_pk_fp8_f32(a[i][j].z * scale, a[i][j].w * scale, pk, true);
      o[j] = (unsigned)pk;
    }
    *(uint4*)(dst + base + i * 4096) = make_uint4(o[0], o[1], o[2], o[3]);
  }
}
__device__ __forceinline__ void convert_item(const float* __restrict__ src, u16* __restrict__ dst, size_t item) {
  size_t base = item * 2048 + (size_t)threadIdx.x * 8;
  const float4* q = (const float4*)(src + base);
  float4 a = q[0], b = q[1];
  *(uint4*)(dst + base) = make_uint4(pack2(a.x, a.y), pack2(a.z, a.w), pack2(b.x, b.y), pack2(b.z, b.w));
}

__device__ __forceinline__ void phase0(const Params& p, char* smem) {
  const int tid = threadIdx.x, lane = tid & 63, w = tid >> 6;
  char* ws = p.ws;
  const int N_IN = 1536, N_BRA = 128, N_BRB = 128, N_OUT = 256, N_Q = 512, N_PG = 256, N_PLE = 64, N_KEYS = 128;
  const int T0 = N_IN, T1 = T0 + N_BRA, T2 = T1 + N_BRB, T3 = T2 + N_OUT, T4 = T3 + N_Q, T5 = T4 + N_PG, T6 = T5 + N_PLE, T7 = T6 + N_KEYS;
  for (int it = blockIdx.x; it < T7; it += gridDim.x) {
    if (it < T0) { int kt = it & 15, nt = it >> 4; int nd0 = nt * 64; int ns0 = nd0 < 4096 ? nd0 : nd0 + 8;
      transpose_tile(p.w_in, 6152, 1024, (u16*)(ws + OFF_WT_IN), kt * 64, ns0, nd0, smem); }
    else if (it < T1) { int i = it - T0; int kt = i & 7, nt = i >> 3; transpose_tile(p.w_br_a, 1024, 512, (u16*)(ws + OFF_WT_BRA), kt * 64, nt * 64, nt * 64, smem); }
    else if (it < T2) { int i = it - T1; int kt = i & 7, nt = i >> 3; transpose_tile(p.w_br_b, 1024, 512, (u16*)(ws + OFF_WT_BRB), kt * 64, nt * 64, nt * 64, smem); }
    else if (it < T3) { int i = it - T2; int kt = i & 15, nt = i >> 4; transpose_tile(p.w_out, 1024, 1024, (u16*)(ws + OFF_WT_OUT), kt * 64, nt * 64, nt * 64, smem); }
    else if (it < T4) { int i = it - T3; int kt = i & 15, nt = i >> 4; transpose_tile(p.peer_wq, 2048, 1024, (u16*)(ws + OFF_WT_Q), kt * 64, nt * 64, nt * 64, smem, p.g_ffn); }
    else if (it < T5) { int i = it - T4; int kt = i & 15, nt = i >> 4; transpose_tile(p.w_ple_gate, 1024, 1024, (u16*)(ws + OFF_WT_PG), kt * 64, nt * 64, nt * 64, smem); }
    else if (it < T6) { int i = it - T5; int kt = i & 3, nt = i >> 2; transpose_tile(p.w_ple, 1024, 256, (u16*)(ws + OFF_WT_PLE), kt * 64, nt * 64, nt * 64, smem); }
    else { convert_item(p.peer_keys, (u16*)(ws + OFF_KEYS), it - T6); }
  }
  __syncthreads();
  float* w8 = (float*)smem;
  for (int i = tid; i < 2048; i += 256) {
    int k = i >> 1, half = i & 1;
    *(float4*)&w8[k * 8 + half * 4] = *(const float4*)(p.w_in + (size_t)k * 6152 + 4096 + half * 4);
  }
  __syncthreads();
  u16* H = (u16*)(ws + OFF_H);
  float* BETA = (float*)(ws + OFF_BETA); float* GLOG = (float*)(ws + OFF_GLOG);
  float* SSQ1 = (float*)(ws + OFF_SSQ1); float* SSQ3 = (float*)(ws + OFF_SSQ3);
  for (int it = blockIdx.x; it < NT / 4; it += gridDim.x) {
    const int row = it * 4 + w;
    const float* xr = xrow(p, row);
    float4 xv[4]; float ss = 0.f;
#pragma unroll
    for (int i = 0; i < 4; i++) { xv[i] = *(const float4*)(xr + i * 256 + lane * 4); ss += xv[i].x * xv[i].x + xv[i].y * xv[i].y + xv[i].z * xv[i].z + xv[i].w * xv[i].w; }
    ss = wsum(ss);
    const float rs = rsqrtf(ss * (1.f / 1024.f) + EPSF);
    float d8[8];
#pragma unroll
    for (int j = 0; j < 8; j++) d8[j] = 0.f;
#pragma unroll
    for (int i = 0; i < 4; i++) {
      const int k = i * 256 + lane * 4;
      float4 g = *(const float4*)(p.g_mix + k);
      float hv[4] = {xv[i].x * rs * g.x, xv[i].y * rs * g.y, xv[i].z * rs * g.z, xv[i].w * rs * g.w};
      *(uint2*)(H + (size_t)row * 1024 + k) = make_uint2(pack2(hv[0], hv[1]), pack2(hv[2], hv[3]));
#pragma unroll
      for (int q = 0; q < 4; q++) {
        float4 wa = *(const float4*)&w8[(k + q) * 8], wb = *(const float4*)&w8[(k + q) * 8 + 4];
        d8[0] += hv[q] * wa.x; d8[1] += hv[q] * wa.y; d8[2] += hv[q] * wa.z; d8[3] += hv[q] * wa.w;
        d8[4] += hv[q] * wb.x; d8[5] += hv[q] * wb.y; d8[6] += hv[q] * wb.z; d8[7] += hv[q] * wb.w;
      }
    }
#pragma unroll
    for (int j = 0; j < 8; j++) d8[j] = wsum(d8[j]);
    if (lane < 4) {
      float bb = lane == 0 ? d8[0] : lane == 1 ? d8[1] : lane == 2 ? d8[2] : d8[3];
      float ab = lane == 0 ? d8[4] : lane == 1 ? d8[5] : lane == 2 ? d8[6] : d8[7];
      BETA[row * 4 + lane] = sigmoidf_(bb);
      float z = ab + p.dt_bias[lane];
      float sp = z > 20.f ? z : log1pf(expf(z));
      GLOG[row * 4 + lane] = -expf(p.a_log[lane]) * sp;
    }
    if (lane == 0) { SSQ1[row] = 0.f; SSQ3[row] = 0.f; }
  }
}

__device__ __forceinline__ void phase1(const Params& p, char* smem) {
  const int tid = threadIdx.x, lane = tid & 63, w = tid >> 6, wm = w >> 1, wn = w & 1;
  char* ws = p.ws;
  const u16* H = (const u16*)(ws + OFF_H);
  const u16* WT = (const u16*)(ws + OFF_WT_IN);
  u16* QA = (u16*)((char*)p.out + OUTB_QA); u16* RAW = (u16*)((char*)p.out + OUTB_RAW);
  float* LOGF = (float*)(ws + OFF_LOGF); u16* VA = (u16*)(ws + OFF_VA);
  u16* OGA = (u16*)(ws + OFF_OGA); u16* ZB = (u16*)(ws + OFF_ZB);
  const int NTILES = 132 * 32;
  for (int it = blockIdx.x; it < NTILES; it += gridDim.x) {
    const int nt = it & 31, mt = it >> 5;
    const int m0 = mt * 128, n0 = nt * 128;
    f32x16 acc[2][2]; zero_acc(acc);
    gemm_mainloop_dma(acc, H + (size_t)m0 * 1024, 1024, WT + (size_t)n0 * 1024, 1024, 1024, smem);
    const int seg = nt >> 2, cb = (nt & 3) * 128;
    if (seg == 1) {
      float* T32 = (float*)smem;
#pragma unroll
      for (int i = 0; i < 2; i++)
#pragma unroll
        for (int j = 0; j < 2; j++) {
          const int cl = wn * 64 + j * 32 + (lane & 31);
          const float p0 = p.lb_param[cb + cl], p1 = p.lb_param[512 + cb + cl];
          const float lb = 1.f / (1.f + __expf(p1 - p0));
#pragma unroll
          for (int e = 0; e < 16; e++) {
            const float f = lb + (1.f - lb) * sigmoidf_(acc[i][j][e]);
            T32[(wm * 64 + i * 32 + rowmap(e, lane)) * 132 + cl] = __logf(f);
          }
        }
      __syncthreads();
#pragma unroll
      for (int q = 0; q < 16; q++) {
        const int idx = tid + 256 * q, row = idx >> 5, c4 = idx & 31;
        *(float4*)(LOGF + (size_t)(m0 + row) * 512 + cb + c4 * 4) = *(const float4*)&T32[row * 132 + c4 * 4];
      }
    } else {
      u16* T = (u16*)smem;
      const bool act = (seg == 0 || seg == 3 || seg == 7);
#pragma unroll
      for (int i = 0; i < 2; i++)
#pragma unroll
        for (int j = 0; j < 2; j++) {
          const int cl = wn * 64 + j * 32 + (lane & 31);
#pragma unroll
          for (int e = 0; e < 16; e++) {
            const float v = acc[i][j][e];
            const int rl = wm * 64 + i * 32 + rowmap(e, lane);
            T[rl * 136 + cl] = f2bf(act ? siluf_(v) : v);
            if (seg >= 4 && seg <= 6) {
              const int row = m0 + rl; const int ch = (seg - 4) * 512 + cb + cl;
              if (row < NTP) { int t = row & 2047; if (t >= 2045) p.out[OUT_CP + ((size_t)(row >> 11) * 3 + (t - 2045)) * 1536 + ch] = v; }
              else { int rs = row - NTP; int t = rs & 3; if (t >= 1) p.out[OUT_CS + ((size_t)(rs >> 2) * 3 + (t - 1)) * 1536 + ch] = v; }
            }
          }
        }
      __syncthreads();
      u16* dst; int ld;
      if (seg == 0) { dst = QA + cb; ld = 512; }
      else if (seg == 2) { dst = VA + cb; ld = 512; }
      else if (seg == 3) { dst = OGA + cb; ld = 512; }
      else if (seg == 7) { dst = ZB + cb; ld = 512; }
      else { dst = RAW + (seg - 4) * 512 + cb; ld = 1536; }
#pragma unroll
      for (int q = 0; q < 8; q++) {
        const int idx = tid + 256 * q, row = idx >> 4, c8 = idx & 15;
        *(uint4*)(dst + (size_t)(m0 + row) * ld + c8 * 8) = *(const uint4*)&T[row * 136 + c8 * 8];
      }
    }
  }
}

__device__ __forceinline__ void gdn_chunk_item(const Params& p, int item, char* smem) {
  const int tid = threadIdx.x, lane = tid & 63, w = tid >> 6;
  const int n = item & 31, bh = item >> 5, h = bh & 3, b = bh >> 2;
  const int tok0 = b * 2048 + n * 64;
  const int ci = 1024 + item;
  char* ws = p.ws;
  u16* Qs = (u16*)smem;
  u16* Ks = (u16*)(smem + 18432);
  float* Ls = (float*)(smem + 36864);
  u16* QKs = (u16*)(smem + 55296);
  float* sm_g = (float*)(smem + 64512);
  float* sm_bt = sm_g + 64; float* sm_gc = sm_g + 128; float* sm_eg = sm_g + 192; float* sm_red = sm_g + 256;
  float* Xs = (float*)(smem + 66560);
  const u16* RAW = (const u16*)((const char*)p.out + OUTB_RAW);
  u16* QB = (u16*)(ws + OFF_QB) + (size_t)ci * 8192;
  u16* KT = (u16*)(ws + OFF_KT) + (size_t)ci * 8192;
  u16* VT = (u16*)(ws + OFF_VT) + (size_t)ci * 8192;
  u16* PN = (u16*)(ws + OFF_PN) + (size_t)item * 16384;
  u16* Oo = (u16*)(ws + OFF_O) + (size_t)NT * 512;
  __syncthreads();
  if (tid < 64) {
    float g = ((const float*)(ws + OFF_GLOG))[(size_t)(tok0 + tid) * 4 + h];
    float bt = ((const float*)(ws + OFF_BETA))[(size_t)(tok0 + tid) * 4 + h];
    float c = g;
#pragma unroll
    for (int o = 1; o < 64; o <<= 1) { float t = __shfl_up(c, o); if (lane >= o) c += t; }
    sm_g[tid] = g; sm_bt[tid] = bt; sm_gc[tid] = c; sm_eg[tid] = __expf(c);
  }
  __syncthreads();
  const float gl = sm_gc[63];
  const int type = tid >> 7, c = tid & 127;
  float val[64];
  float vv[64];
  {
    u16* tile = (u16*)Xs;
    for (int i = tid; i < 67 * 48; i += 256) {
      const int row = i / 48, rem = i - row * 48, seg = rem >> 4, c8 = rem & 15;
      uint4 v4 = make_uint4(0, 0, 0, 0);
      if (n > 0 || row >= 3) v4 = *(const uint4*)(RAW + (size_t)(tok0 - 3 + row) * 1536 + seg * 512 + h * 128 + c8 * 8);
      *(uint4*)&tile[row * 384 + seg * 128 + c8 * 8] = v4;
    }
    __syncthreads();
    {
      const int col = type * 512 + h * 128 + c;
      const float w0 = p.conv_w[col], w1 = p.conv_w[1536 + col], w2 = p.conv_w[3072 + col], w3 = p.conv_w[4608 + col];
      const u16* tp = tile + type * 128 + c;
      float x0 = bf2f(tp[0]), x1 = bf2f(tp[384]), x2 = bf2f(tp[768]);
#pragma unroll
      for (int t = 0; t < 64; t++) {
        float x3 = bf2f(tp[(t + 3) * 384]);
        float cv = x0 * w0 + x1 * w1 + x2 * w2 + x3 * w3;
        val[t] = siluf_(cv);
        x0 = x1; x1 = x2; x2 = x3;
      }
    }
    float sq[64];
#pragma unroll
    for (int t = 0; t < 64; t++) sq[t] = val[t] * val[t];
    float part = transpose_reduce64(sq, lane);
    sm_red[(type * 2 + (w & 1)) * 64 + lane] = part;
  }
  __syncthreads();
  {
    u16* Xs = type ? Ks : Qs;
    const float sc = type ? 1.f : 0.08838834764831845f;
#pragma unroll
    for (int t = 0; t < 64; t++) {
      float rn = rsqrtf(sm_red[(type * 2) * 64 + t] + sm_red[(type * 2 + 1) * 64 + t] + EPSF) * sc;
      val[t] *= rn;
      Xs[t * 136 + c] = f2bf(val[t]);
    }
  }
  {
    const u16* tile = (const u16*)Xs;
  if (type == 0) {
    const int col = 1024 + h * 128 + c;
    const float w0 = p.conv_w[col], w1 = p.conv_w[1536 + col], w2 = p.conv_w[3072 + col], w3 = p.conv_w[4608 + col];
    const u16* tp = tile + 256 + c;
    float x0 = bf2f(tp[0]), x1 = bf2f(tp[384]), x2 = bf2f(tp[768]);
#pragma unroll
    for (int t = 0; t < 64; t++) {
      float x3 = bf2f(tp[(t + 3) * 384]);
      float cv = x0 * w0 + x1 * w1 + x2 * w2 + x3 * w3;
      vv[t] = siluf_(cv) * sm_bt[t];
      x0 = x1; x1 = x2; x2 = x3;
    }
  }
  }
  __syncthreads();
#pragma unroll
  for (int q = 0; q < 4; q++) {
    const int idx = tid + 256 * q, row = idx >> 4, c8 = idx & 15;
    const uint4 v4 = *(const uint4*)&Qs[row * 136 + c8 * 8];
    const float eg = sm_eg[row];
    *(uint4*)&QB[row * 128 + c8 * 8] = make_uint4(pack2(bflo(v4.x) * eg, bfhi(v4.x) * eg), pack2(bflo(v4.y) * eg, bfhi(v4.y) * eg),
                                                   pack2(bflo(v4.z) * eg, bfhi(v4.z) * eg), pack2(bflo(v4.w) * eg, bfhi(v4.w) * eg));
  }
  {
    const int mi = w >> 1, ni = w & 1, r = lane & 31, hh = (lane >> 5) * 8;
    f32x16 kk = zero16(), qk = zero16();
#pragma unroll
    for (int ks = 0; ks < 8; ks++) {
      bf16x8 ak = *(const bf16x8*)&Ks[(mi * 32 + r) * 136 + ks * 16 + hh];
      bf16x8 bk = *(const bf16x8*)&Ks[(ni * 32 + r) * 136 + ks * 16 + hh];
      bf16x8 aq = *(const bf16x8*)&Qs[(mi * 32 + r) * 136 + ks * 16 + hh];
      kk = mfma16(ak, bk, kk); qk = mfma16(aq, bk, qk);
    }
    const int s = ni * 32 + r; const float gcs = sm_gc[s];
#pragma unroll
    for (int e = 0; e < 16; e++) {
      const int t = mi * 32 + rowmap(e, lane);
      float gam = (s <= t) ? __expf(sm_gc[t] - gcs) : 0.f;
      Ls[t * 68 + s] = (s < t) ? sm_bt[t] * gam * kk[e] : 0.f;
      QKs[t * 72 + s] = f2bf(qk[e] * gam);
    }
  }
  __syncthreads();
  if (type == 1) {
    u16* kdT = Qs;
    unsigned pk[32];
#pragma unroll
    for (int s2 = 0; s2 < 32; s2++) pk[s2] = pack2(val[2 * s2] * __expf(gl - sm_gc[2 * s2]), val[2 * s2 + 1] * __expf(gl - sm_gc[2 * s2 + 1]));
#pragma unroll
    for (int q = 0; q < 8; q++) {
      uint4 v4 = make_uint4(pk[4 * q], pk[4 * q + 1], pk[4 * q + 2], pk[4 * q + 3]);
      *(uint4*)&kdT[c * 72 + q * 8] = v4;
      *(uint4*)&KT[c * 64 + q * 8] = v4;
    }
#pragma unroll
    for (int t = 0; t < 64; t++) Xs[t * 256 + tid] = sm_bt[t] * sm_eg[t] * val[t];
  } else {
#pragma unroll
    for (int t = 0; t < 64; t++) Xs[t * 256 + tid] = vv[t];
  }
  {
    float* xc = Xs + tid;
#pragma unroll 1
    for (int b4 = 0; b4 < 16; b4++) {
      const int t0 = b4 * 4;
      float a0 = xc[t0 * 256], a1 = xc[(t0 + 1) * 256], a2 = xc[(t0 + 2) * 256], a3 = xc[(t0 + 3) * 256];
      const float* l0p = Ls + t0 * 68;
#pragma unroll 2
      for (int sg = 0; sg < b4; sg++) {
        const float4 l0 = *(const float4*)&l0p[sg * 4], l1 = *(const float4*)&l0p[68 + sg * 4];
        const float4 l2 = *(const float4*)&l0p[136 + sg * 4], l3 = *(const float4*)&l0p[204 + sg * 4];
        const float* xp = xc + sg * 1024;
        const float x0 = xp[0], x1 = xp[256], x2 = xp[512], x3 = xp[768];
        a0 -= l0.x * x0; a0 -= l0.y * x1; a0 -= l0.z * x2; a0 -= l0.w * x3;
        a1 -= l1.x * x0; a1 -= l1.y * x1; a1 -= l1.z * x2; a1 -= l1.w * x3;
        a2 -= l2.x * x0; a2 -= l2.y * x1; a2 -= l2.z * x2; a2 -= l2.w * x3;
        a3 -= l3.x * x0; a3 -= l3.y * x1; a3 -= l3.z * x2; a3 -= l3.w * x3;
      }
      const float4 d1 = *(const float4*)&l0p[68 + t0], d2 = *(const float4*)&l0p[136 + t0], d3 = *(const float4*)&l0p[204 + t0];
      a1 -= d1.x * a0;
      a2 -= d2.x * a0; a2 -= d2.y * a1;
      a3 -= d3.x * a0; a3 -= d3.y * a1; a3 -= d3.z * a2;
      xc[t0 * 256] = a0; xc[(t0 + 1) * 256] = a1; xc[(t0 + 2) * 256] = a2; xc[(t0 + 3) * 256] = a3;
    }
#pragma unroll
    for (int t = 0; t < 64; t++) val[t] = xc[t * 256];
  }
  __syncthreads();
  {
    u16* dstL = type == 0 ? (u16*)Ls : Ks;
#pragma unroll
    for (int q = 0; q < 8; q++) {
      uint4 v4 = make_uint4(pack2(val[8 * q], val[8 * q + 1]), pack2(val[8 * q + 2], val[8 * q + 3]), pack2(val[8 * q + 4], val[8 * q + 5]), pack2(val[8 * q + 6], val[8 * q + 7]));
      *(uint4*)&dstL[c * 72 + q * 8] = v4;
      if (type == 0) *(uint4*)&VT[c * 64 + q * 8] = v4;
    }
  }
  __syncthreads();
  {
    const u16* U0T = (const u16*)Ls; const u16* WTl = Ks; const u16* kdT = Qs;
    u16* O0T = (u16*)Xs; u16* QWT = O0T + 64 * 136; u16* PNT = QWT + 64 * 136;
    const int r = lane & 31, hh = (lane >> 5) * 8;
    const int mi = w & 1, ni0 = (w >> 1) * 2;
#pragma unroll
    for (int jj = 0; jj < 2; jj++) {
      const int ni = ni0 + jj;
      f32x16 o0 = zero16(), qw = zero16();
#pragma unroll
      for (int ks = 0; ks < 4; ks++) {
        bf16x8 a = *(const bf16x8*)&QKs[(mi * 32 + r) * 72 + ks * 16 + hh];
        bf16x8 bu = *(const bf16x8*)&U0T[(ni * 32 + r) * 72 + ks * 16 + hh];
        bf16x8 bw = *(const bf16x8*)&WTl[(ni * 32 + r) * 72 + ks * 16 + hh];
        o0 = mfma16(a, bu, o0); qw = mfma16(a, bw, qw);
      }
      const int col = ni * 32 + r;
#pragma unroll
      for (int e = 0; e < 16; e++) {
        const int t = mi * 32 + rowmap(e, lane);
        O0T[t * 136 + col] = f2bf(o0[e]);
        QWT[t * 136 + col] = f2bf(qw[e]);
      }
    }
#pragma unroll
    for (int ni = 0; ni < 4; ni++) {
      f32x16 pn = zero16();
#pragma unroll
      for (int ks = 0; ks < 4; ks++) {
        bf16x8 a = *(const bf16x8*)&kdT[(w * 32 + r) * 72 + ks * 16 + hh];
        bf16x8 bw = *(const bf16x8*)&WTl[(ni * 32 + r) * 72 + ks * 16 + hh];
        pn = mfma16(a, bw, pn);
      }
#pragma unroll
      for (int e = 0; e < 16; e++) PNT[(w * 32 + rowmap(e, lane)) * 136 + ni * 32 + r] = f2bf(-pn[e]);
    }
    if (tid < 128) ((float*)(ws + OFF_DVEC))[(size_t)ci * 128 + tid] = __expf(gl);
    __syncthreads();
#pragma unroll
    for (int q = 0; q < 4; q++) {
      const int idx = tid + 256 * q, row = idx >> 4, c8 = idx & 15;
      *(uint4*)&Oo[(size_t)(tok0 + row) * 512 + h * 128 + c8 * 8] = *(const uint4*)&O0T[row * 136 + c8 * 8];
      const uint4 a4 = *(const uint4*)&QB[row * 128 + c8 * 8];
      const uint4 w4 = *(const uint4*)&QWT[row * 136 + c8 * 8];
      *(uint4*)&QB[row * 128 + c8 * 8] = make_uint4(pack2(bflo(a4.x) - bflo(w4.x), bfhi(a4.x) - bfhi(w4.x)), pack2(bflo(a4.y) - bflo(w4.y), bfhi(a4.y) - bfhi(w4.y)),
                                                     pack2(bflo(a4.z) - bflo(w4.z), bfhi(a4.z) - bfhi(w4.z)), pack2(bflo(a4.w) - bflo(w4.w), bfhi(a4.w) - bfhi(w4.w)));
    }
#pragma unroll
    for (int q = 0; q < 8; q++) {
      const int idx = tid + 256 * q, row = idx >> 4, c8 = idx & 15;
      *(uint4*)&PN[row * 128 + c8 * 8] = *(const uint4*)&PNT[row * 136 + c8 * 8];
    }
  }
}

__device__ __forceinline__ void hgrn_chunk_item(const Params& p, int item, char* smem) {
  const int tid = threadIdx.x, lane = tid & 63, w = tid >> 6;
  const int n = item & 31, bh = item >> 5, h = bh & 3, b = bh >> 2;
  const int tok0 = b * 2048 + n * 64;
  const int ci = item;
  char* ws = p.ws;
  u16* Qt = (u16*)smem;
  u16* Kt = (u16*)(smem + 17408);
  u16* ATT = (u16*)(smem + 34816);
  u16* VTs = (u16*)(smem + 44032);
  const float* LOGF = (const float*)(ws + OFF_LOGF);
  const u16* QA = (const u16*)((const char*)p.out + OUTB_QA);
  const u16* VA = (const u16*)(ws + OFF_VA);
  u16* QB = (u16*)(ws + OFF_QB) + (size_t)ci * 8192;
  u16* KT = (u16*)(ws + OFF_KT) + (size_t)ci * 8192;
  u16* VT = (u16*)(ws + OFF_VT) + (size_t)ci * 8192;
  u16* Oo = (u16*)(ws + OFF_O);
  __syncthreads();
  const int d = tid & 127, half = tid >> 7;
  const int colb = h * 128 + d;
  float* LFs = (float*)(smem + 62464);
  u16* QAs = (u16*)(smem + 95232);
  u16* VAs = (u16*)(smem + 111616);
  u16* OT = (u16*)LFs;
  {
#pragma unroll
    for (int q = 0; q < 8; q++) {
      const int i = tid + 256 * q; const int row = i >> 5, c4 = i & 31;
      *(float4*)&LFs[row * 128 + c4 * 4] = *(const float4*)(LOGF + (size_t)(tok0 + row) * 512 + h * 128 + c4 * 4);
    }
#pragma unroll
    for (int q = 0; q < 4; q++) {
      const int i = tid + 256 * q; const int row = i >> 4, c8 = i & 15;
      *(uint4*)&QAs[row * 128 + c8 * 8] = *(const uint4*)(QA + (size_t)(tok0 + row) * 512 + h * 128 + c8 * 8);
      *(uint4*)&VAs[row * 128 + c8 * 8] = *(const uint4*)(VA + (size_t)(tok0 + row) * 512 + h * 128 + c8 * 8);
    }
  }
  __syncthreads();
  float bc[64];
  {
    float run = 0.f;
#pragma unroll
    for (int t = 0; t < 64; t++) { run += LFs[t * 128 + d]; bc[t] = run; }
  }
  const float rref = bc[31], bl = bc[63];
  if (half == 0) {
#pragma unroll
    for (int t = 0; t < 64; t++) {
      float q = bf2f(QAs[t * 128 + d]);
      Qt[t * 136 + d] = f2bf(q * __expf(bc[t] - rref));
      QAs[t * 128 + d] = f2bf(q * __expf(bc[t]));
    }
    ((float*)(ws + OFF_DVEC))[(size_t)ci * 128 + d] = __expf(bl);
  } else {
    unsigned pk[32];
    float kprev = 0.f;
#pragma unroll
    for (int t = 0; t < 64; t++) {
      float lf2 = LFs[t * 128 + d];
      float k = 1.f - __expf(lf2);
      Kt[t * 136 + d] = f2bf(k * __expf(rref - bc[t]));
      float kh = k * __expf(bl - bc[t]);
      if (t & 1) pk[t >> 1] = pack2(kprev, kh); else kprev = kh;
    }
#pragma unroll
    for (int q = 0; q < 8; q++) *(uint4*)&KT[d * 64 + q * 8] = make_uint4(pk[4 * q], pk[4 * q + 1], pk[4 * q + 2], pk[4 * q + 3]);
  }
  {
    unsigned pk[16];
#pragma unroll
    for (int s2 = 0; s2 < 16; s2++) {
      u16 a = VAs[(half * 32 + 2 * s2) * 128 + d];
      u16 b2 = VAs[(half * 32 + 2 * s2 + 1) * 128 + d];
      pk[s2] = (unsigned)a | ((unsigned)b2 << 16);
    }
#pragma unroll
    for (int q = 0; q < 4; q++) {
      uint4 v4 = make_uint4(pk[4 * q], pk[4 * q + 1], pk[4 * q + 2], pk[4 * q + 3]);
      *(uint4*)&VTs[d * 72 + half * 32 + q * 8] = v4;
      *(uint4*)&VT[d * 64 + half * 32 + q * 8] = v4;
    }
  }
  __syncthreads();
#pragma unroll
  for (int q = 0; q < 4; q++) {
    const int idx = tid + 256 * q, row = idx >> 4, c8 = idx & 15;
    *(uint4*)&QB[row * 128 + c8 * 8] = *(const uint4*)&QAs[row * 128 + c8 * 8];
  }
  {
    const int mi = w >> 1, ni = w & 1, r = lane & 31, hh = (lane >> 5) * 8;
    f32x16 at = zero16();
#pragma unroll
    for (int ks = 0; ks < 8; ks++) {
      bf16x8 a = *(const bf16x8*)&Qt[(mi * 32 + r) * 136 + ks * 16 + hh];
      bf16x8 bb = *(const bf16x8*)&Kt[(ni * 32 + r) * 136 + ks * 16 + hh];
      at = mfma16(a, bb, at);
    }
    const int s = ni * 32 + r;
#pragma unroll
    for (int e = 0; e < 16; e++) { const int t = mi * 32 + rowmap(e, lane); ATT[t * 72 + s] = f2bf(s <= t ? at[e] : 0.f); }
  }
  __syncthreads();
  {
    const int r = lane & 31, hh = (lane >> 5) * 8;
    const int mi = w & 1, ni0 = (w >> 1) * 2;
#pragma unroll
    for (int jj = 0; jj < 2; jj++) {
      const int ni = ni0 + jj;
      f32x16 o0 = zero16();
#pragma unroll
      for (int ks = 0; ks < 4; ks++) {
        bf16x8 a = *(const bf16x8*)&ATT[(mi * 32 + r) * 72 + ks * 16 + hh];
        bf16x8 bv = *(const bf16x8*)&VTs[(ni * 32 + r) * 72 + ks * 16 + hh];
        o0 = mfma16(a, bv, o0);
      }
#pragma unroll
      for (int e = 0; e < 16; e++) OT[(mi * 32 + rowmap(e, lane)) * 136 + ni * 32 + r] = f2bf(o0[e]);
    }
    __syncthreads();
#pragma unroll
    for (int q = 0; q < 4; q++) {
      const int idx = tid + 256 * q, row = idx >> 4, c8 = idx & 15;
      *(uint4*)&Oo[(size_t)(tok0 + row) * 512 + h * 128 + c8 * 8] = *(const uint4*)&OT[row * 136 + c8 * 8];
    }
  }
}

__device__ __forceinline__ void hgrn_sample_item(const Params& p, int item, char* smem) {
  const int tid = threadIdx.x, lane = tid & 63, w = tid >> 6;
  const int bs = item >> 2, h = item & 3;
  char* ws = p.ws;
  float* fq = (float*)smem;
  float* ff = fq + 512; float* fk = ff + 512; float* fv = fk + 512; float* part = fv + 512;
  float* red = part + 256;
  const float* LOGF = (const float*)(ws + OFF_LOGF);
  const u16* QA = (const u16*)((const char*)p.out + OUTB_QA);
  const u16* VA = (const u16*)(ws + OFF_VA);
  const int tokb = NTP + bs * 4;
  __syncthreads();
  if (tid < 128) {
#pragma unroll
    for (int t = 0; t < 4; t++) {
      size_t idx = (size_t)(tokb + t) * 512 + h * 128 + tid;
      float lf = LOGF[idx];
      ff[t * 128 + tid] = __expf(lf); fk[t * 128 + tid] = -expm1f(lf);
      fq[t * 128 + tid] = bf2f(QA[idx]); fv[t * 128 + tid] = bf2f(VA[idx]);
    }
  }
  __syncthreads();
  const int v = tid & 127, dh = tid >> 7;
  const float* s0 = p.state_hgrn + ((size_t)(bs * 4 + h) * 128 + dh * 64) * 128 + v;
  float S[64];
#pragma unroll
  for (int i = 0; i < 64; i++) S[i] = s0[(size_t)i * 128];
  float o4[4];
#pragma unroll
  for (int t = 0; t < 4; t++) {
    float os = 0.f; const float vv = fv[t * 128 + v];
#pragma unroll
    for (int i = 0; i < 64; i++) {
      const int dd = dh * 64 + i;
      S[i] = ff[t * 128 + dd] * S[i] + fk[t * 128 + dd] * vv;
      os += S[i] * fq[t * 128 + dd];
    }
    part[dh * 128 + v] = os;
    __syncthreads();
    o4[t] = part[v] + part[128 + v];
    __syncthreads();
  }
  float* so = p.out + OUT_HS + ((size_t)(bs * 4 + h) * 128 + dh * 64) * 128 + v;
#pragma unroll
  for (int i = 0; i < 64; i++) so[(size_t)i * 128] = S[i];
  u16* Oo = (u16*)(ws + OFF_O);
  float* SSQO = (float*)(ws + OFF_SSQO);
  if (dh == 0) {
#pragma unroll
    for (int t = 0; t < 4; t++) {
      Oo[(size_t)(tokb + t) * 512 + h * 128 + v] = f2bf(o4[t]);
      float s = wsum(o4[t] * o4[t]);
      if (lane == 0) red[t * 2 + w] = s;
    }
  }
  __syncthreads();
  if (tid < 4) {
    float* q = SSQO + ((size_t)(tokb + tid) * 4 + h) * 4;
    q[0] = red[tid * 2] + red[tid * 2 + 1]; q[1] = 0.f; q[2] = 0.f; q[3] = 0.f;
  }
}

__device__ __forceinline__ void gdn_sample_item(const Params& p, int item, char* smem) {
  const int tid = threadIdx.x, lane = tid & 63, w = tid >> 6;
  const int bs = item >> 2, h = item & 3;
  char* ws = p.ws;
  float* cq = (float*)smem;
  float* ck = cq + 512; float* cv = ck + 512; float* part = cv + 512;
  float* red = part + 256;
  float* sg = red + 16;
  const u16* RAW = (const u16*)((const char*)p.out + OUTB_RAW);
  const int tokb = NTP + bs * 4;
  __syncthreads();
  float cval[4];
  {
    const int type = tid >> 7, c = tid & 127;
    const int col = type * 512 + h * 128 + c;
    const float w0 = p.conv_w[col], w1 = p.conv_w[1536 + col], w2 = p.conv_w[3072 + col], w3 = p.conv_w[4608 + col];
    const float* sc = p.state_conv + (size_t)bs * 3 * 1536 + col;
    float x0 = sc[0], x1 = sc[1536], x2 = sc[3072];
#pragma unroll
    for (int t = 0; t < 4; t++) {
      float x3 = bf2f(RAW[(size_t)(tokb + t) * 1536 + col]);
      float c4 = x0 * w0 + x1 * w1 + x2 * w2 + x3 * w3;
      cval[t] = siluf_(c4);
      x0 = x1; x1 = x2; x2 = x3;
      float s = wsum(cval[t] * cval[t]);
      if (lane == 0) red[t * 4 + w] = s;
    }
  }
  if (tid < 128) {
    const int col = 1024 + h * 128 + tid;
    const float w0 = p.conv_w[col], w1 = p.conv_w[1536 + col], w2 = p.conv_w[3072 + col], w3 = p.conv_w[4608 + col];
    const float* sc = p.state_conv + (size_t)bs * 3 * 1536 + col;
    float x0 = sc[0], x1 = sc[1536], x2 = sc[3072];
#pragma unroll
    for (int t = 0; t < 4; t++) {
      float x3 = bf2f(RAW[(size_t)(tokb + t) * 1536 + col]);
      float c4 = x0 * w0 + x1 * w1 + x2 * w2 + x3 * w3;
      cv[t * 128 + tid] = siluf_(c4);
      x0 = x1; x1 = x2; x2 = x3;
    }
  }
  if (tid < 4) {
    sg[tid] = __expf(((const float*)(ws + OFF_GLOG))[(size_t)(tokb + tid) * 4 + h]);
    sg[4 + tid] = ((const float*)(ws + OFF_BETA))[(size_t)(tokb + tid) * 4 + h];
  }
  __syncthreads();
  {
    const int type = tid >> 7, c = tid & 127;
    float* dst = type ? ck : cq;
#pragma unroll
    for (int t = 0; t < 4; t++) {
      float rn = rsqrtf(red[t * 4 + type * 2] + red[t * 4 + type * 2 + 1] + EPSF);
      if (type == 0) rn *= 0.08838834764831845f;
      dst[t * 128 + c] = cval[t] * rn;
    }
  }
  __syncthreads();
  const int v = tid & 127, dh = tid >> 7;
  const float* s0 = p.state_delta + ((size_t)(bs * 4 + h) * 128 + dh * 64) * 128 + v;
  float S[64];
#pragma unroll
  for (int i = 0; i < 64; i++) S[i] = s0[(size_t)i * 128];
  float o4[4];
#pragma unroll
  for (int t = 0; t < 4; t++) {
    const float a = sg[t], bt = sg[4 + t];
    float ks = 0.f;
#pragma unroll
    for (int i = 0; i < 64; i++) ks += ck[t * 128 + dh * 64 + i] * S[i];
    part[dh * 128 + v] = ks;
    __syncthreads();
    const float kS = part[v] + part[128 + v];
    __syncthreads();
    const float u = bt * (cv[t * 128 + v] - a * kS);
    float os = 0.f;
#pragma unroll
    for (int i = 0; i < 64; i++) {
      const int dd = dh * 64 + i;
      S[i] = a * S[i] + ck[t * 128 + dd] * u;
      os += S[i] * cq[t * 128 + dd];
    }
    part[dh * 128 + v] = os;
    __syncthreads();
    o4[t] = part[v] + part[128 + v];
    __syncthreads();
  }
  float* so = p.out + OUT_DS + ((size_t)(bs * 4 + h) * 128 + dh * 64) * 128 + v;
#pragma unroll
  for (int i = 0; i < 64; i++) so[(size_t)i * 128] = S[i];
  u16* Oo = (u16*)(ws + OFF_O) + (size_t)NT * 512;
  float* SSQO = (float*)(ws + OFF_SSQO) + (size_t)NT * 16;
  if (dh == 0) {
#pragma unroll
    for (int t = 0; t < 4; t++) {
      Oo[(size_t)(tokb + t) * 512 + h * 128 + v] = f2bf(o4[t]);
      float s = wsum(o4[t] * o4[t]);
      if (lane == 0) red[t * 4 + w] = s;
    }
  }
  __syncthreads();
  if (tid < 4) {
    float* q = SSQO + ((size_t)(tokb + tid) * 4 + h) * 4;
    q[0] = red[tid * 4] + red[tid * 4 + 1]; q[1] = 0.f; q[2] = 0.f; q[3] = 0.f;
  }
}

__device__ __forceinline__ void phase2(const Params& p, char* smem, int lo = 0, int hi = 3072) {
  const int g = gridDim.x, bx = blockIdx.x;
#pragma unroll 1
  for (int it = lo + bx; it < hi && it < 1024; it += g) gdn_chunk_item(p, it, smem);
#pragma unroll 1
  for (int it = lo + bx + ((lo < 1024) ? ((1024 - lo - bx + g - 1) / g) * g : 0); it < hi && it < 2048; it += g) if (it >= 1024) hgrn_chunk_item(p, it - 1024, smem);
#pragma unroll 1
  for (int it = lo + bx + ((lo < 2048) ? ((2048 - lo - bx + g - 1) / g) * g : 0); it < hi && it < 2560; it += g) if (it >= 2048) gdn_sample_item(p, it - 2048, smem);
#pragma unroll 1
  for (int it = lo + bx + ((lo < 2560) ? ((2560 - lo - bx + g - 1) / g) * g : 0); it < hi; it += g) if (it >= 2560) hgrn_sample_item(p, it - 2560, smem);
}

__device__ __forceinline__ void seq_item(const Params& p, int item, char* smem, const bool write_o = true) {
  const int tid = threadIdx.x, lane = tid & 63, w = tid >> 6;
  const int m = 1 - (item >> 7); const int rem = item & 127; const int bh = rem >> 2, sl = rem & 3; const int b = bh >> 2, h = bh & 3;
  char* ws = p.ws;
  u16* STs = (u16*)smem;
  u16* VTs = (u16*)(smem + 8704);
  const int r = lane & 31, hh = (lane >> 5) * 8;
  const int dcol = w * 32 + r;
  u16* Om = (u16*)(ws + OFF_O) + (size_t)m * NT * 512;
  float* SSQO = (float*)(ws + OFF_SSQO) + (size_t)m * NT * 16;
  const float* DVEC = (const float*)(ws + OFF_DVEC);
  f32x16 S = zero16();
  __syncthreads();
  uint4 vt4; bf16x8 ktf[4], pnf[8], qbf[8]; float dvn; u16 o0[16];
#define SEQ_LOADS(n_)                                                                                           \
  {                                                                                                             \
    const int ci_ = m * 1024 + bh * 32 + (n_);                                                                  \
    const u16* QB_ = (const u16*)(ws + OFF_QB) + (size_t)ci_ * 8192;                                            \
    const u16* KT_ = (const u16*)(ws + OFF_KT) + (size_t)ci_ * 8192;                                            \
    const u16* VT_ = (const u16*)(ws + OFF_VT) + (size_t)ci_ * 8192;                                            \
    const u16* PN_ = (const u16*)(ws + OFF_PN) + (size_t)(bh * 32 + (n_)) * 16384;                              \
    vt4 = *(const uint4*)(VT_ + (sl * 32 + (tid >> 3)) * 64 + (tid & 7) * 8);                                   \
    dvn = DVEC[(size_t)ci_ * 128 + dcol];                                                                       \
    _Pragma("unroll") for (int ks = 0; ks < 4; ks++) ktf[ks] = *(const bf16x8*)(KT_ + dcol * 64 + ks * 16 + hh); \
    if (m == 1) { _Pragma("unroll") for (int ks = 0; ks < 8; ks++) pnf[ks] = *(const bf16x8*)(PN_ + dcol * 128 + ks * 16 + hh); } \
    if (w < 2) {                                                                                                \
      _Pragma("unroll") for (int ks = 0; ks < 8; ks++) qbf[ks] = *(const bf16x8*)(QB_ + (w * 32 + r) * 128 + ks * 16 + hh); \
      const int tok0_ = b * 2048 + (n_) * 64;                                                                   \
      _Pragma("unroll") for (int e = 0; e < 16; e++) o0[e] = Om[(size_t)(tok0_ + w * 32 + rowmap(e, lane)) * 512 + h * 128 + sl * 32 + r]; \
    }                                                                                                           \
  }
  SEQ_LOADS(0)
#pragma unroll 1
  for (int n = 0; n < 32; n++) {
#pragma unroll
    for (int e = 0; e < 16; e++) STs[rowmap(e, lane) * 136 + dcol] = f2bf(S[e]);
    *(uint4*)&VTs[(tid >> 3) * 72 + (tid & 7) * 8] = vt4;
    __syncthreads();
    const int tok0 = b * 2048 + n * 64;
    if (w < 2) {
      f32x16 o;
#pragma unroll
      for (int e = 0; e < 16; e++) o[e] = bf2f(o0[e]);
#pragma unroll
      for (int ks = 0; ks < 8; ks++) {
        bf16x8 bb = *(const bf16x8*)&STs[r * 136 + ks * 16 + hh];
        o = mfma16(qbf[ks], bb, o);
      }
#pragma unroll
      for (int e = 0; e < 16; e++) {
        const int t = w * 32 + rowmap(e, lane);
        if (write_o) Om[(size_t)(tok0 + t) * 512 + h * 128 + sl * 32 + r] = f2bf(o[e]);
        float sq = sum32(o[e] * o[e]);
        if (r == 0) SSQO[((size_t)(tok0 + t) * 4 + h) * 4 + sl] = sq;
      }
    }
#pragma unroll
    for (int e = 0; e < 16; e++) S[e] *= dvn;
#pragma unroll
    for (int ks = 0; ks < 4; ks++) {
      bf16x8 a = *(const bf16x8*)&VTs[r * 72 + ks * 16 + hh];
      S = mfma16(a, ktf[ks], S);
    }
    if (m == 1) {
#pragma unroll
      for (int ks = 0; ks < 8; ks++) {
        bf16x8 a = *(const bf16x8*)&STs[r * 136 + ks * 16 + hh];
        S = mfma16(a, pnf[ks], S);
      }
    }
    if (n + 1 < 32) SEQ_LOADS(n + 1)
    __syncthreads();
  }
  float* so = p.out + (m == 0 ? OUT_HP : OUT_DP) + (size_t)bh * 16384;
#pragma unroll
  for (int g = 0; g < 4; g++) {
    const int v0 = 8 * g + (lane >> 5) * 4;
    *(float4*)(so + (size_t)dcol * 128 + sl * 32 + v0) = make_float4(S[4 * g], S[4 * g + 1], S[4 * g + 2], S[4 * g + 3]);
  }
}
__device__ __forceinline__ void phase3(const Params& p, char* smem, const bool write_o = true) {
  for (int it = blockIdx.x; it < 256; it += gridDim.x) seq_item(p, it, smem, write_o);
}

__device__ __forceinline__ void phase4a(const Params& p, char* smem) {
  const int tid = threadIdx.x, lane = tid & 63, w = tid >> 6, wm = w >> 1, wn = w & 1;
  char* ws = p.ws;
  const u16* H = (const u16*)(ws + OFF_H);
  const u16* WTIN = (const u16*)(ws + OFF_WT_IN);
  u16* MRG = (u16*)(ws + OFF_MRG);
  const int NG = 132 * 8;
  const int NCONV = 4096;
  float* gnL = (float*)(smem + 141312);
  if (tid < 128) { gnL[tid] = p.g_norm_a[tid]; gnL[128 + tid] = p.g_norm_b[tid]; }
  __syncthreads();
  const int G = (int)gridDim.x;
  const int nfull = NG / G;
  const int nleft = NG - nfull * G;
  const bool split_ok = (2 * nleft <= G) && (nleft <= P4A_MAX_LEFT);
  const int bx = (int)blockIdx.x;
  int nunits = 2 * nfull;
  if (split_ok) { if (bx < 2 * nleft) nunits += 1; } else { if (bx < nleft) nunits += 2; }
  u16* MRG2 = (u16*)(ws + OFF_MRG2);
#pragma unroll 1
  for (int un = 0; un < nunits; un++) {
    int it, mix; bool side = false;
    if (un < 2 * nfull) { it = bx + (un >> 1) * G; mix = un & 1; }
    else if (split_ok) { it = nfull * G + (bx >> 1); mix = bx & 1; side = (mix == 1); }
    else { it = nfull * G + bx; mix = un & 1; }
    const bool add = (mix == 1) && !side;
    const int nt = it & 7, mt = it >> 3;
    const int m0 = mt * 128, n0 = nt * 128;
    unsigned sg[2][2][8];
    f32x16 acc[2][2];
    {
      zero_acc(acc);
      LoadBf16 lh{H + (size_t)m0 * 1024, 1024};
      gemm_mainloop(acc, lh, WTIN + (size_t)(4096 + mix * 1024 + n0) * 1024, 1024, 1024, smem);
#pragma unroll
      for (int i = 0; i < 2; i++)
#pragma unroll
        for (int j = 0; j < 2; j++)
#pragma unroll
          for (int e = 0; e < 8; e++) sg[i][j][e] = pack2(sigmoidf_(acc[i][j][2 * e]), sigmoidf_(acc[i][j][2 * e + 1]));
      zero_acc(acc);
      float* rstdL = (float*)(smem + 139264);
      {
        const float* sq = (const float*)(ws + OFF_SSQO) + ((size_t)mix * NT + m0) * 16;
        const float4 s0 = *(const float4*)(sq + tid * 8), s1 = *(const float4*)(sq + tid * 8 + 4);
        rstdL[tid * 2] = rsqrtf((s0.x + s0.y + s0.z + s0.w) * (1.f / 128.f) + EPSF);
        rstdL[tid * 2 + 1] = rsqrtf((s1.x + s1.y + s1.z + s1.w) * (1.f / 128.f) + EPSF);
      }
      LoadNormO lo{(const u16*)(ws + OFF_O) + ((size_t)mix * NT + m0) * 512,
                   (const u16*)(ws + (mix ? OFF_ZB : OFF_OGA)) + (size_t)m0 * 512,
                   rstdL, gnL + mix * 128};
      gemm_mainloop(acc, lo, (const u16*)(ws + (mix ? OFF_WT_BRB : OFF_WT_BRA)) + (size_t)n0 * 512, 512, 512, smem);
      {
        u16* T = (u16*)smem;
#pragma unroll
        for (int i = 0; i < 2; i++)
#pragma unroll
          for (int j = 0; j < 2; j++)
#pragma unroll
            for (int e = 0; e < 16; e++) {
              const float g0 = (e & 1) ? bfhi(sg[i][j][e >> 1]) : bflo(sg[i][j][e >> 1]);
              T[(wm * 64 + i * 32 + rowmap(e, lane)) * 136 + wn * 64 + j * 32 + (lane & 31)] = f2bf(g0 * acc[i][j][e]);
            }
        __syncthreads();
        u16* dbase = side ? MRG2 + (size_t)(it - nfull * G) * 16384 : MRG + (size_t)m0 * 1024 + n0;
        const int dld = side ? 128 : 1024;
#pragma unroll
        for (int q = 0; q < 8; q++) {
          const int idx = tid + 256 * q, row = idx >> 4, c8 = idx & 15;
          uint4 v4 = *(const uint4*)&T[row * 136 + c8 * 8];
          u16* mp = dbase + (size_t)row * dld + c8 * 8;
          if (add) {
            const uint4 o4 = *(const uint4*)mp;
            v4.x = pack2(bflo(v4.x) + bflo(o4.x), bfhi(v4.x) + bfhi(o4.x));
            v4.y = pack2(bflo(v4.y) + bflo(o4.y), bfhi(v4.y) + bfhi(o4.y));
            v4.z = pack2(bflo(v4.z) + bflo(o4.z), bfhi(v4.z) + bfhi(o4.z));
            v4.w = pack2(bflo(v4.w) + bflo(o4.w), bfhi(v4.w) + bfhi(o4.w));
          }
          *(uint4*)mp = v4;
        }
      }
    }
  }
  {
    const int extra = split_ok ? 2 * nleft : nleft;
    int first = bx - extra, stride = G - extra;
    if (stride <= 0) { first = bx; stride = G; }
    if (first >= 0) {
#pragma unroll 1
      for (int ci = first; ci < NCONV; ci += stride) {
        if (ci < 2048) convert_item_fp8(p.expert_u, (unsigned char*)(ws + OFF_EU), ci, EU_SCALE);
        else convert_item_fp8(p.expert_v, (unsigned char*)(ws + OFF_EV), ci - 2048, EV_SCALE);
      }
    }
  }
}

__device__ __forceinline__ void phase4a_fixup(const Params& p) {
  const int tid = threadIdx.x;
  char* ws = p.ws;
  const int NG = 132 * 8, G = (int)gridDim.x;
  const int nfull = NG / G, nleft = NG - nfull * G;
  const bool split_ok = (2 * nleft <= G) && (nleft <= P4A_MAX_LEFT);
  if (!split_ok || (int)blockIdx.x >= nleft) return;
  const int it = nfull * G + (int)blockIdx.x;
  const int nt = it & 7, mt = it >> 3;
  u16* MRG = (u16*)(ws + OFF_MRG) + (size_t)mt * 128 * 1024 + nt * 128;
  const u16* MRG2 = (const u16*)(ws + OFF_MRG2) + (size_t)blockIdx.x * 16384;
#pragma unroll
  for (int q = 0; q < 8; q++) {
    const int idx = tid + 256 * q, row = idx >> 4, c8 = idx & 15;
    u16* mp = MRG + (size_t)row * 1024 + c8 * 8;
    uint4 v4 = *(const uint4*)mp;
    const uint4 o4 = *(const uint4*)(MRG2 + row * 128 + c8 * 8);
    v4.x = pack2(bflo(v4.x) + bflo(o4.x), bfhi(v4.x) + bfhi(o4.x));
    v4.y = pack2(bflo(v4.y) + bflo(o4.y), bfhi(v4.y) + bfhi(o4.y));
    v4.z = pack2(bflo(v4.z) + bflo(o4.z), bfhi(v4.z) + bfhi(o4.z));
    v4.w = pack2(bflo(v4.w) + bflo(o4.w), bfhi(v4.w) + bfhi(o4.w));
    *(uint4*)mp = v4;
  }
}

__device__ __forceinline__ void phase4b(const Params& p, char* smem) {
  const int tid = threadIdx.x, lane = tid & 63, w = tid >> 6, wm = w >> 1, wn = w & 1;
  char* ws = p.ws;
  const u16* MRG = (const u16*)(ws + OFF_MRG);
  float* X1 = p.out + OUT_Y;
  float* SSQ1 = (float*)(ws + OFF_SSQ1);
  for (int it = blockIdx.x; it < 132 * 8; it += gridDim.x) {
    const int nt = it & 7, mt = it >> 3;
    const int m0 = mt * 128, n0 = nt * 128;
    f32x16 acc[2][2]; zero_acc(acc);
    LoadBf16 al{MRG + (size_t)m0 * 1024, 1024};
    gemm_mainloop(acc, al, (const u16*)(ws + OFF_WT_OUT) + (size_t)n0 * 1024, 1024, 1024, smem);
#pragma unroll
    for (int i = 0; i < 2; i++)
#pragma unroll
      for (int e = 0; e < 16; e++) {
        const int row = m0 + wm * 64 + i * 32 + rowmap(e, lane);
        const float* xr = xrow(p, row);
        float sq = 0.f;
#pragma unroll
        for (int j = 0; j < 2; j++) {
          const int col = n0 + wn * 64 + j * 32 + (lane & 31);
          float v = acc[i][j][e] + xr[col];
          X1[(size_t)row * 1024 + col] = v;
          ((u16*)smem)[(row - m0) * 136 + (col - n0)] = f2bf(v);
          sq += v * v;
        }
        sq = sum32(sq);
        if ((lane & 31) == 0) atomicAdd(&SSQ1[row], sq);
      }
    {
      const u16* T = (const u16*)smem;
      u16* X1B = (u16*)(ws + OFF_X1B);
      __syncthreads();
#pragma unroll
      for (int q = 0; q < 8; q++) {
        const int idx = tid + 256 * q, row = idx >> 4, c8 = idx & 15;
        *(uint4*)(X1B + (size_t)(m0 + row) * 1024 + n0 + c8 * 8) = *(const uint4*)&T[row * 136 + c8 * 8];
      }
    }
  }
}

__device__ __forceinline__ void phase4c(const Params& p, char* smem) {
  const int tid = threadIdx.x, lane = tid & 63, w = tid >> 6, wm = w >> 1, wn = w & 1;
  char* ws = p.ws;
  const float* X1 = p.out + OUT_Y;
  const float* SSQ1 = (const float*)(ws + OFF_SSQ1);
  u16* H2 = (u16*)(ws + OFF_H2);
  float* TOPS = (float*)(ws + OFF_TOPS); int* TOPI = (int*)(ws + OFF_TOPI);
  const u16* KEYS = (const u16*)(ws + OFF_KEYS);
  for (int it = blockIdx.x; it < 132 * 16; it += gridDim.x) {
    const int nt = it & 15, mt = it >> 4;
    const int m0 = mt * 128, n0 = nt * 128;
    f32x16 acc[2][2]; zero_acc(acc);
    gemm_mainloop_dma(acc, (const u16*)(ws + OFF_X1B) + (size_t)m0 * 1024, 1024, (const u16*)(ws + OFF_WT_Q) + (size_t)n0 * 1024, 1024, 1024, smem);
    u16* Aq = (u16*)smem;
    u16* Bk = Aq + 128 * 136;
    const int r = lane & 31, hh = (lane >> 5) * 8;
#pragma unroll
    for (int i = 0; i < 2; i++)
#pragma unroll
      for (int j = 0; j < 2; j++)
#pragma unroll
        for (int e = 0; e < 16; e++) {
          const int rl = wm * 64 + i * 32 + rowmap(e, lane);
          const float rs = rsqrtf(SSQ1[m0 + rl] * (1.f / 1024.f) + EPSF);
          Aq[rl * 136 + wn * 64 + j * 32 + r] = f2bf(acc[i][j][e] * rs);
        }
#pragma unroll
    for (int q = 0; q < 8; q++) {
      int idx = tid + 256 * q; int row = idx >> 4, ch = idx & 15;
      *(uint4*)&Bk[row * 136 + ch * 8] = *(const uint4*)(KEYS + ((size_t)nt * 128 + row) * 128 + ch * 8);
    }
    __syncthreads();
    zero_acc(acc);
#pragma unroll
    for (int ks = 0; ks < 8; ks++) {
      bf16x8 a[2], bq[2];
#pragma unroll
      for (int i = 0; i < 2; i++) a[i] = *(const bf16x8*)&Aq[(wm * 64 + i * 32 + r) * 136 + ks * 16 + hh];
#pragma unroll
      for (int j = 0; j < 2; j++) bq[j] = *(const bf16x8*)&Bk[(wn * 64 + j * 32 + r) * 136 + ks * 16 + hh];
#pragma unroll
      for (int i = 0; i < 2; i++)
#pragma unroll
        for (int j = 0; j < 2; j++) acc[i][j] = mfma16(a[i], bq[j], acc[i][j]);
    }
    __syncthreads();
    float* SC = (float*)smem;
#pragma unroll
    for (int i = 0; i < 2; i++)
#pragma unroll
      for (int j = 0; j < 2; j++)
#pragma unroll
        for (int e = 0; e < 16; e++) SC[(wm * 64 + i * 32 + rowmap(e, lane)) * 132 + wn * 64 + j * 32 + r] = acc[i][j][e];
    __syncthreads();
    {
      const int tokl = tid >> 1, part = tid & 1;
      float sv[64];
#pragma unroll
      for (int i = 0; i < 16; i++) {
        float4 x = *(const float4*)&SC[tokl * 132 + part * 64 + i * 4];
        const unsigned ib = 127u - (unsigned)(part * 64 + i * 4);
        sv[4 * i]     = __uint_as_float((__float_as_uint(x.x) & ~127u) | ib);
        sv[4 * i + 1] = __uint_as_float((__float_as_uint(x.y) & ~127u) | (ib - 1u));
        sv[4 * i + 2] = __uint_as_float((__float_as_uint(x.z) & ~127u) | (ib - 2u));
        sv[4 * i + 3] = __uint_as_float((__float_as_uint(x.w) & ~127u) | (ib - 3u));
      }
#define CE_DESC(a, b) { const float hi_ = fmaxf(a, b), lo_ = fminf(a, b); a = hi_; b = lo_; }
#pragma unroll
      for (int g = 0; g < 4; g++) {
#pragma unroll
        for (int lk = 1; lk <= 4; lk++) {
#pragma unroll
          for (int lj = lk - 1; lj >= 0; lj--) {
#pragma unroll
            for (int i = 0; i < 16; i++) {
              const int l = i ^ (1 << lj);
              if (l > i) {
                if ((i & (1 << lk)) == 0) { CE_DESC(sv[g * 16 + i], sv[g * 16 + l]) } else { CE_DESC(sv[g * 16 + l], sv[g * 16 + i]) }
              }
            }
          }
        }
      }
#define MERGE16(A0, B0)                                                                             \
      {                                                                                             \
        _Pragma("unroll") for (int i = 0; i < 16; i++) sv[(A0) + i] = fmaxf(sv[(A0) + i], sv[(B0) + 15 - i]); \
        _Pragma("unroll") for (int lj = 3; lj >= 0; lj--) {                                         \
          _Pragma("unroll") for (int i = 0; i < 16; i++) {                                          \
            const int l = i ^ (1 << lj);                                                            \
            if (l > i) { CE_DESC(sv[(A0) + i], sv[(A0) + l]) }                                      \
          }                                                                                         \
        }                                                                                           \
      }
      MERGE16(0, 16)
      MERGE16(32, 48)
      MERGE16(0, 32)
#pragma unroll
      for (int i = 0; i < 16; i++) sv[16 + i] = DPP_F(sv[i], 0xB1);
      MERGE16(0, 16)
      if (part == 0) {
        const size_t ob = ((size_t)(m0 + tokl) * 16 + nt) * 16;
#pragma unroll
        for (int q = 0; q < 4; q++) {
          *(float4*)(TOPS + ob + q * 4) = make_float4(sv[4 * q], sv[4 * q + 1], sv[4 * q + 2], sv[4 * q + 3]);
          *(int4*)(TOPI + ob + q * 4) = make_int4(127 - (int)(__float_as_uint(sv[4 * q]) & 127u), 127 - (int)(__float_as_uint(sv[4 * q + 1]) & 127u),
                                                  127 - (int)(__float_as_uint(sv[4 * q + 2]) & 127u), 127 - (int)(__float_as_uint(sv[4 * q + 3]) & 127u));
        }
      }
    }
  }
}

__device__ __forceinline__ float gelu_tanh(float x) {
  float u = 0.7978845608028654f * (x + 0.044715f * x * x * x);
  return 0.5f * x * (1.f + tanhf(u));
}
__device__ const unsigned char cand_tab[56] = {
  0x00,0x01,0x02,0x03,0x04,0x05,0x06,0x07,0x08,0x09,0x0a,0x0b,0x0c,0x0d,0x0e,0x0f,
  0x10,0x11,0x12,0x13,0x14,0x15,0x16,0x17,
  0x20,0x21,0x22,0x23,0x24,
  0x30,0x31,0x32,0x33,
  0x40,0x41,0x42,
  0x50,0x51, 0x60,0x61, 0x70,0x71,
  0x80,0x90,0xa0,0xb0,0xc0,0xd0,0xe0,0xf0,
  0,0,0,0,0,0};

#define P5_LOAD(A, TAB, j0)                                                                \
  _Pragma("unroll") for (int q = 0; q < 16; q++) {                                         \
    A[q] = ((const uint4*)((TAB) + (size_t)widx[(j0) + q] * 1024))[lane];                  \
  }
#define P5_FMA2(acc_, d_, i_)                                                              \
  acc_ = __builtin_elementwise_fma(__builtin_amdgcn_cvt_pk_f32_fp8((int)(d_), false), h2[2 * (i_)], acc_); \
  acc_ = __builtin_elementwise_fma(__builtin_amdgcn_cvt_pk_f32_fp8((int)(d_), true), h2[2 * (i_) + 1], acc_);
#define P5_COMPUTE_U(A, j0)                                                                                 \
  {                                                                                                         \
    float d_[16];                                                                                           \
    _Pragma("unroll") for (int q = 0; q < 16; q++) {                                                        \
      float2v ac_ = {0.f, 0.f};                                                                             \
      P5_FMA2(ac_, A[q].x, 0) P5_FMA2(ac_, A[q].y, 1) P5_FMA2(ac_, A[q].z, 2) P5_FMA2(ac_, A[q].w, 3)       \
      d_[q] = ac_.x + ac_.y;                                                                                \
    }                                                                                                       \
    _Pragma("unroll") for (int i = 0; i < 8; i++) { bool hi_ = lane & 32; float sd = hi_ ? d_[i] : d_[i + 8]; float kp = hi_ ? d_[i + 8] : d_[i]; d_[i] = kp + __shfl_xor(sd, 32); } \
    _Pragma("unroll") for (int i = 0; i < 4; i++) { bool hi_ = lane & 16; float sd = hi_ ? d_[i] : d_[i + 4]; float kp = hi_ ? d_[i + 4] : d_[i]; d_[i] = kp + __shfl_xor(sd, 16); } \
    _Pragma("unroll") for (int i = 0; i < 2; i++) { bool hi_ = lane & 8; float sd = hi_ ? d_[i] : d_[i + 2]; float kp = hi_ ? d_[i + 2] : d_[i]; d_[i] = kp + __shfl_xor(sd, 8); }   \
    { bool hi_ = lane & 4; float sd = hi_ ? d_[0] : d_[1]; float kp = hi_ ? d_[1] : d_[0]; d_[0] = kp + __shfl_xor(sd, 4); }   \
    float a_ = d_[0];                                                                                       \
    a_ += DPP_F(a_, 0x4E); a_ += DPP_F(a_, 0xB1);                                                           \
    if ((lane & 3) == 0) { const int j_ = (j0) + (lane >> 2); wwt[j_] = wgate[j_] * gelu_tanh(a_ * (1.f / EU_SCALE)) * (1.f / EV_SCALE); } \
  }
#define P5_ACC2(d_, i_, w2_)                                                               \
  o2[2 * (i_)] = __builtin_elementwise_fma(__builtin_amdgcn_cvt_pk_f32_fp8((int)(d_), false), w2_, o2[2 * (i_)]); \
  o2[2 * (i_) + 1] = __builtin_elementwise_fma(__builtin_amdgcn_cvt_pk_f32_fp8((int)(d_), true), w2_, o2[2 * (i_) + 1]);
#define P5_COMPUTE_V(A, j0)                                                                                 \
  _Pragma("unroll") for (int q = 0; q < 16; q++) {                                                          \
    const float wt = wwt[(j0) + q];                                                                         \
    const float2v w2_ = {wt, wt};                                                                           \
    P5_ACC2(A[q].x, 0, w2_) P5_ACC2(A[q].y, 1, w2_) P5_ACC2(A[q].z, 2, w2_) P5_ACC2(A[q].w, 3, w2_)         \
  }

__device__ __forceinline__ void phase5(const Params& p, char* smem, const bool store_x = true) {
  const int tid = threadIdx.x, lane = tid & 63, w = tid >> 6;
  char* ws = p.ws;
  int* widx = (int*)(smem + w * 4096);
  float* wgate = (float*)(smem + w * 4096 + 512);
  float* wwt = (float*)(smem + w * 4096 + 1024);
  int* wcnt = (int*)(smem + w * 4096 + 1536);
  float* tsL = (float*)(smem + w * 4096 + 2048);
  int* tiL = (int*)(smem + w * 4096 + 3072);
  unsigned char* ctab = (unsigned char*)(smem + 16384);
  const float* TOPS = (const float*)(ws + OFF_TOPS); const int* TOPI = (const int*)(ws + OFF_TOPI);
  const u16* H2 = (const u16*)(ws + OFF_H2);
  const unsigned char* EU = (const unsigned char*)(ws + OFF_EU); const unsigned char* EV = (const unsigned char*)(ws + OFF_EV);
  float* X = p.out + OUT_Y;
  u16* H3 = (u16*)(ws + OFF_H3);
  __syncthreads();
  if (tid < 56) ctab[tid] = cand_tab[tid];
  __syncthreads();
  uint4 pf_ts, pf_ti, pf_ha, pf_hb; float pf_ss = 1.f;
  const u16* X1B = (const u16*)(ws + OFF_X1B);
  const float* SSQ1 = (const float*)(ws + OFF_SSQ1);
  float2v gf[8];
#pragma unroll
  for (int i = 0; i < 4; i++) { const float4 g4 = *(const float4*)(p.g_ffn + lane * 16 + i * 4); gf[2 * i] = float2v{g4.x, g4.y}; gf[2 * i + 1] = float2v{g4.z, g4.w}; }
  {
    const int tok0 = (int)blockIdx.x * 4 + w;
    if (tok0 < NT) {
      pf_ts = ((const uint4*)(TOPS + (size_t)tok0 * 256))[lane];
      pf_ti = ((const uint4*)(TOPI + (size_t)tok0 * 256))[lane];
      pf_ha = *(const uint4*)(X1B + (size_t)tok0 * 1024 + lane * 16);
      pf_hb = *(const uint4*)(X1B + (size_t)tok0 * 1024 + lane * 16 + 8);
      pf_ss = SSQ1[tok0];
    }
  }
  for (int it = blockIdx.x; it < NT / 4; it += gridDim.x) {
    const int tok = it * 4 + w;
    float* xr = X + (size_t)tok * 1024 + lane * 16;
    const float4 xv0 = *(const float4*)(xr), xv1 = *(const float4*)(xr + 4), xv2 = *(const float4*)(xr + 8), xv3 = *(const float4*)(xr + 12);
    ((uint4*)tsL)[lane] = pf_ts;
    ((uint4*)tiL)[lane] = pf_ti;
    const uint4 cur_ha = pf_ha, cur_hb = pf_hb; const float cur_rs = rsqrtf(pf_ss * (1.f / 1024.f) + EPSF);
    {
      const int itn = it + (int)gridDim.x;
      if (itn < NT / 4) {
        const int tokn = itn * 4 + w;
        pf_ts = ((const uint4*)(TOPS + (size_t)tokn * 256))[lane];
        pf_ti = ((const uint4*)(TOPI + (size_t)tokn * 256))[lane];
        pf_ha = *(const uint4*)(X1B + (size_t)tokn * 1024 + lane * 16);
        pf_hb = *(const uint4*)(X1B + (size_t)tokn * 1024 + lane * 16 + 8);
        pf_ss = SSQ1[tokn];
      }
    }
    {
      const int hd = lane >> 3, g = lane & 7;
      const float* ts = tsL + hd * 32;
      const int* ti = tiL + hd * 32;
      float key[7]; int ij[7];
#pragma unroll
      for (int sl = 0; sl < 7; sl++) {
        const int cid = g * 7 + sl;
        const int t = ctab[cid];
        ij[sl] = t;
        float sum = ts[t >> 4] + ts[16 + (t & 15)];
        unsigned k = (__float_as_uint(sum) & ~63u) | (unsigned)cid;
        key[sl] = cid < 50 ? __uint_as_float(k) : NINF;
      }
      if (lane < 8) wcnt[lane] = 0;
      float m = 3.0e38f, m1 = 0.f;
#pragma unroll 1
      for (int rd = 0; rd < 16; rd++) {
        float loc = NINF;
#pragma unroll
        for (int sl = 0; sl < 7; sl++) loc = fmaxf(loc, key[sl] < m ? key[sl] : NINF);
        loc = fmaxf(loc, DPP_F(loc, 0xB1)); loc = fmaxf(loc, DPP_F(loc, 0x4E)); loc = fmaxf(loc, DPP_F(loc, 0x141));
        if (rd == 0) m1 = loc;
        m = loc;
      }
      float ev[7]; float es = 0.f;
#pragma unroll
      for (int sl = 0; sl < 7; sl++) { ev[sl] = key[sl] >= m ? __expf(key[sl] - m1) : 0.f; es += ev[sl]; }
      es += DPP_F(es, 0xB1); es += DPP_F(es, 0x4E); es += DPP_F(es, 0x141);
      const float inv = 1.f / es;
      int cnt = 0;
#pragma unroll
      for (int sl = 0; sl < 7; sl++) cnt += (key[sl] >= m) ? 1 : 0;
      int xs = cnt, tsh;
      tsh = __builtin_amdgcn_update_dpp(0, xs, 0x111, 0xF, 0xF, true); if (g >= 1) xs += tsh;
      tsh = __builtin_amdgcn_update_dpp(0, xs, 0x112, 0xF, 0xF, true); if (g >= 2) xs += tsh;
      tsh = __builtin_amdgcn_update_dpp(0, xs, 0x114, 0xF, 0xF, true); if (g >= 4) xs += tsh;
      int pos = xs - cnt;
#pragma unroll
      for (int sl = 0; sl < 7; sl++) {
        if (key[sl] >= m) {
          int ia = ti[ij[sl] >> 4], ib = ti[16 + (ij[sl] & 15)];
          widx[hd * 16 + pos] = ia * 128 + ib;
          wgate[hd * 16 + pos] = ev[sl] * inv;
          pos++;
        }
      }
    }
    float2v h2[8];
    {
      const uint4 a = cur_ha;
      const uint4 b2 = cur_hb;
      h2[0] = float2v{bflo(a.x), bfhi(a.x)}; h2[1] = float2v{bflo(a.y), bfhi(a.y)}; h2[2] = float2v{bflo(a.z), bfhi(a.z)}; h2[3] = float2v{bflo(a.w), bfhi(a.w)};
      h2[4] = float2v{bflo(b2.x), bfhi(b2.x)}; h2[5] = float2v{bflo(b2.y), bfhi(b2.y)}; h2[6] = float2v{bflo(b2.z), bfhi(b2.z)}; h2[7] = float2v{bflo(b2.w), bfhi(b2.w)};
#pragma unroll
      for (int i = 0; i < 8; i++) h2[i] = h2[i] * gf[i] * cur_rs;
    }
    uint4 A0[16], A1[16];
    P5_LOAD(A0, EU, 0)
#pragma unroll 1
    for (int j0 = 0; j0 < 128; j0 += 32) {
      P5_LOAD(A1, EU, j0 + 16)
      P5_COMPUTE_U(A0, j0)
      if (j0 + 32 < 128) { P5_LOAD(A0, EU, j0 + 32) } else { P5_LOAD(A0, EV, 0) }
      P5_COMPUTE_U(A1, j0 + 16)
    }
    float2v o2[8];
#pragma unroll
    for (int i = 0; i < 8; i++) o2[i] = float2v{0.f, 0.f};
#pragma unroll 1
    for (int j0 = 0; j0 < 128; j0 += 32) {
      P5_LOAD(A1, EV, j0 + 16)
      P5_COMPUTE_V(A0, j0)
      if (j0 + 32 < 128) { P5_LOAD(A0, EV, j0 + 32) }
      P5_COMPUTE_V(A1, j0 + 16)
    }
    float x2[16];
#pragma unroll
    for (int i = 0; i < 4; i++) {
      const float4 xv = i == 0 ? xv0 : i == 1 ? xv1 : i == 2 ? xv2 : xv3;
      x2[4 * i] = xv.x + o2[2 * i].x; x2[4 * i + 1] = xv.y + o2[2 * i].y; x2[4 * i + 2] = xv.z + o2[2 * i + 1].x; x2[4 * i + 3] = xv.w + o2[2 * i + 1].y;
    }
    float ss = 0.f;
#pragma unroll
    for (int i = 0; i < 16; i++) ss += x2[i] * x2[i];
    ss = wsum(ss);
    const float rs = rsqrtf(ss * (1.f / 1024.f) + EPSF);
    if (store_x) {
#pragma unroll
      for (int i = 0; i < 4; i++) *(float4*)(xr + i * 4) = make_float4(x2[4 * i], x2[4 * i + 1], x2[4 * i + 2], x2[4 * i + 3]);
    }
    unsigned hp[8];
#pragma unroll
    for (int i = 0; i < 4; i++) {
      const float4 g = *(const float4*)(p.g_ple + lane * 16 + i * 4);
      hp[2 * i] = pack2(x2[4 * i] * rs * g.x, x2[4 * i + 1] * rs * g.y);
      hp[2 * i + 1] = pack2(x2[4 * i + 2] * rs * g.z, x2[4 * i + 3] * rs * g.w);
    }
    *(uint4*)(H3 + (size_t)tok * 1024 + lane * 16) = make_uint4(hp[0], hp[1], hp[2], hp[3]);
    *(uint4*)(H3 + (size_t)tok * 1024 + lane * 16 + 8) = make_uint4(hp[4], hp[5], hp[6], hp[7]);
  }
}

__device__ __forceinline__ void phase6(const Params& p, char* smem) {
  const int tid = threadIdx.x, lane = tid & 63, w = tid >> 6, wm = w >> 1, wn = w & 1;
  char* ws = p.ws;
  const u16* H3 = (const u16*)(ws + OFF_H3);
  float* X = p.out + OUT_Y;
  float* SSQ3 = (float*)(ws + OFF_SSQ3);
  for (int it = blockIdx.x; it < 132 * 8; it += gridDim.x) {
    const int nt = it & 7, mt = it >> 3;
    const int m0 = mt * 128, n0 = nt * 128;
    f32x16 acc1[2][2]; zero_acc(acc1);
    unsigned pe[2][2][8];
    {
      LoadF32 lp{m0 < NTP ? p.p_prompt + (size_t)m0 * 256 : p.p_sample + (size_t)(m0 - NTP) * 256, 256};
      gemm_mainloop(acc1, lp, (const u16*)(ws + OFF_WT_PLE) + (size_t)n0 * 256, 256, 256, smem);
#pragma unroll
      for (int i = 0; i < 2; i++)
#pragma unroll
        for (int j = 0; j < 2; j++)
#pragma unroll
          for (int e = 0; e < 8; e++) pe[i][j][e] = pack2(acc1[i][j][2 * e], acc1[i][j][2 * e + 1]);
      zero_acc(acc1);
    }
    LoadBf16 al{H3 + (size_t)m0 * 1024, 1024};
    gemm_mainloop(acc1, al, (const u16*)(ws + OFF_WT_PG) + (size_t)n0 * 1024, 1024, 1024, smem);
#pragma unroll
    for (int i = 0; i < 2; i++)
#pragma unroll
      for (int e = 0; e < 16; e++) {
        const int row = m0 + wm * 64 + i * 32 + rowmap(e, lane);
        float sq = 0.f;
#pragma unroll
        for (int j = 0; j < 2; j++) {
          const int col = n0 + wn * 64 + j * 32 + (lane & 31);
          float* xp = X + (size_t)row * 1024 + col;
          float v = *xp + ((e & 1) ? bfhi(pe[i][j][e >> 1]) : bflo(pe[i][j][e >> 1])) * sigmoidf_(acc1[i][j][e]);
          *xp = v;
          sq += v * v;
        }
        sq = sum32(sq);
        if ((lane & 31) == 0) atomicAdd(&SSQ3[row], sq);
      }
  }
}

__device__ __forceinline__ void phase7(const Params& p) {
  const int tid = threadIdx.x;
  float* X = p.out + OUT_Y;
  const float* SSQ3 = (const float*)(p.ws + OFF_SSQ3);
  for (int it = blockIdx.x; it < NT / 2; it += gridDim.x) {
    const size_t base = (size_t)it * 2048 + (size_t)tid * 8;
    const int row = (int)(base >> 10), k = (int)(base & 1023);
    const float rs = rsqrtf(SSQ3[row] * (1.f / 1024.f) + EPSF);
    float4 a = *(const float4*)(X + base), b = *(const float4*)(X + base + 4);
    float4 g0 = *(const float4*)(p.g_final + k), g1 = *(const float4*)(p.g_final + k + 4);
    *(float4*)(X + base) = make_float4(a.x * rs * g0.x, a.y * rs * g0.y, a.z * rs * g0.z, a.w * rs * g0.w);
    *(float4*)(X + base + 4) = make_float4(b.x * rs * g1.x, b.y * rs * g1.y, b.z * rs * g1.z, b.w * rs * g1.w);
  }
}

#define XB_TMO      128
#define XB_XCNT(j)  (256  + 64 * (j))
#define XB_XSUB(j)  (1280 + 64 * (j))
#define XB_XGEN(j)  (2304 + 64 * (j))
#define XB_TOP      3328
#define XB_TOPGEN   3392
#define XCD_BAR_WORDS 3456
#define XB_SPIN_CAP (1u << 22)
#define LAS __attribute__((address_space(3)))
__device__ __forceinline__ unsigned xb_ld(unsigned* p)              { return __hip_atomic_load(p, __ATOMIC_RELAXED, __HIP_MEMORY_SCOPE_AGENT); }
__device__ __forceinline__ unsigned xb_add(unsigned* p, unsigned v) { return __hip_atomic_fetch_add(p, v, __ATOMIC_RELAXED, __HIP_MEMORY_SCOPE_AGENT); }
__device__ __forceinline__ unsigned xb_xcc_id() { return (unsigned)__builtin_amdgcn_s_getreg((3 << 11) | 20) & 0xFu; }
#define XB_SPIN(cond, bar) do { unsigned _sp = 0; while (cond) { __builtin_amdgcn_s_sleep(1); \
    if ((++_sp & 255u) == 0u) { if (xb_ld(&(bar)[XB_TMO])) break; if (_sp > XB_SPIN_CAP) { atomicAdd(&(bar)[XB_TMO], 1u); break; } } } } while (0)
struct XcdBarrier { unsigned* bar; unsigned x; volatile LAS unsigned* st; };
__device__ __forceinline__ XcdBarrier xcd_barrier_post(unsigned* bar, volatile LAS unsigned* st) {
    XcdBarrier b; b.bar = bar; b.x = xb_xcc_id(); b.st = st;
    if (threadIdx.x == 0) (void)xb_add(&bar[XB_XCNT(b.x)], 1u);
    return b;
}
__device__ __forceinline__ void xcd_barrier_complete(unsigned* bar, unsigned x, unsigned& nloc, unsigned& nx) {
    const unsigned G = gridDim.x * gridDim.y * gridDim.z;
    unsigned sum, cnt, mine, sp = 0u;
    for (;;) {
        sum = 0u; cnt = 0u; mine = 0u;
#pragma unroll
        for (unsigned j = 0; j < 16; ++j) { const unsigned c = xb_ld(&bar[XB_XCNT(j)]); sum += c; cnt += (c > 0u) ? 1u : 0u; mine = (j == x) ? c : mine; }
        if (sum == G) break;
        __builtin_amdgcn_s_sleep(1);
        if ((++sp & 255u) == 0u) { if (xb_ld(&bar[XB_TMO])) break; if (sp > XB_SPIN_CAP) { atomicAdd(&bar[XB_TMO], 1u); break; } }
    }
    nloc = mine > 0u ? mine : 1u; nx = cnt > 0u ? cnt : 1u;
}
__device__ __forceinline__ void xcd_barrier(const XcdBarrier& b) {
    asm volatile("s_waitcnt vmcnt(0)" ::: "memory");
    __syncthreads();
    if (threadIdx.x == 0) {
        unsigned* bar = b.bar;
        __builtin_amdgcn_s_waitcnt(0);
        unsigned nloc = b.st[0], nx = b.st[1];
        if (nloc == 0u) { xcd_barrier_complete(bar, b.x, nloc, nx); b.st[0] = nloc; b.st[1] = nx; }
        const unsigned old = xb_add(&bar[XB_XSUB(b.x)], 1u);
        const unsigned gen = old / nloc;
        if (old + 1u == (gen + 1u) * nloc) {
            __builtin_amdgcn_fence(__ATOMIC_RELEASE, "agent");
            asm volatile("s_waitcnt vmcnt(0)" ::: "memory");
            const unsigned og = xb_add(&bar[XB_TOP], 1u);
            const unsigned tg = og / nx;
            if (og + 1u == (tg + 1u) * nx) xb_add(&bar[XB_TOPGEN], 1u);
            else XB_SPIN(xb_ld(&bar[XB_TOPGEN]) == tg, bar);
            __builtin_amdgcn_fence(__ATOMIC_ACQUIRE, "agent");
            xb_add(&bar[XB_XGEN(b.x)], 1u);
            asm volatile("s_waitcnt vmcnt(0)" ::: "memory");
        } else {
            XB_SPIN(xb_ld(&bar[XB_XGEN(b.x)]) == gen, bar);
            __builtin_amdgcn_fence(__ATOMIC_ACQUIRE, "agent");
            asm volatile("s_waitcnt vmcnt(0)" ::: "memory");
        }
    }
    __syncthreads();
}

__global__ void __launch_bounds__(256) mega_kernel(Params p) {
  __shared__ __attribute__((aligned(16))) char smem[SMEM_BYTES];
  cg::grid_group grid = cg::this_grid();
  __shared__ uint4 xb_words;
  if (threadIdx.x == 0) xb_words = make_uint4(0u, 0u, 0u, 0u);
  __syncthreads();
  XcdBarrier xb = xcd_barrier_post((unsigned*)(p.ws + OFF_BAR), (volatile LAS unsigned*)&xb_words);
  phase0(p, smem);
  if (p.ws == nullptr) grid.sync();
  xcd_barrier(xb);
#if PROBE == 9
  for (int i = 0; i < 20; i++) xcd_barrier(xb);
#endif
#if PROBE == 10
  phase0(p, smem);
  xcd_barrier(xb);
#endif
  phase1(p, smem);
  xcd_barrier(xb);
#if PROBE == 1
  phase1(p, smem);
  xcd_barrier(xb);
#endif
  phase2(p, smem);
  xcd_barrier(xb);
#if PROBE == 2
  phase2(p, smem);
  xcd_barrier(xb);
#endif
#if PROBE == 21
  phase2(p, smem, 0, 1024);
  xcd_barrier(xb);
#endif
#if PROBE == 22
  phase2(p, smem, 1024, 2048);
  xcd_barrier(xb);
#endif
#if PROBE == 23
  phase2(p, smem, 2048, 3072);
  xcd_barrier(xb);
#endif
#if PROBE == 6
  phase3(p, smem, false);
  xcd_barrier(xb);
#endif
  phase3(p, smem);
  xcd_barrier(xb);
  phase4a(p, smem);
  xcd_barrier(xb);
  phase4a_fixup(p);
  xcd_barrier(xb);
#if PROBE == 3
  phase4a(p, smem);
  xcd_barrier(xb);
#endif
  phase4b(p, smem);
  xcd_barrier(xb);
  phase4c(p, smem);
  xcd_barrier(xb);
#if PROBE == 4
  phase4c(p, smem);
  xcd_barrier(xb);
#endif
#if PROBE == 5
  phase5(p, smem, false);
  xcd_barrier(xb);
#endif
  phase5(p, smem);
  xcd_barrier(xb);
  phase6(p, smem);
  xcd_barrier(xb);
  phase7(p);
}

extern "C" void kernel_launch(void* const* d_in, const int* in_sizes, int n_in, void* d_out, int out_size,
                              void* d_ws, size_t ws_size, hipStream_t stream) {
  static int grid_blocks = 0;
  if (!grid_blocks) {
    int dev = 0, cus = 0, per_cu = 0;
    hipGetDevice(&dev);
    hipDeviceGetAttribute(&cus, hipDeviceAttributeMultiprocessorCount, dev);
    hipOccupancyMaxActiveBlocksPerMultiprocessor(&per_cu, mega_kernel, 256, 0);
    if (per_cu > 2) per_cu = 2;
    if (per_cu < 1) per_cu = 1;
    grid_blocks = cus * per_cu;
  }
  if (ws_size < WS_TOTAL) { fprintf(stderr, "workspace too small: %zu < %zu\n", ws_size, (size_t)WS_TOTAL); return; }
  Params p{};
  const float** pf = (const float**)&p;
  for (int i = 0; i < 27; i++) pf[i] = (const float*)d_in[i];
  p.out = (float*)d_out;
  p.ws = (char*)d_ws;
  hipMemsetAsync((char*)d_ws + OFF_BAR, 0, 16384, stream);
  void* args[] = {&p};
  hipError_t e = hipLaunchCooperativeKernel((void*)mega_kernel, dim3(grid_blocks), dim3(256), args, 0, stream);
  if (e != hipSuccess) fprintf(stderr, "cooperative launch failed: %s (grid %d)\n", hipGetErrorString(e), grid_blocks);
}
```

```cpp
#include <hip/hip_runtime.h>
#include <hip/hip_cooperative_groups.h>
#include <stdint.h>
#include <stdio.h>
namespace cg = cooperative_groups;

typedef unsigned short u16;
typedef __attribute__((ext_vector_type(8))) short bf16x8;
typedef __attribute__((ext_vector_type(16))) float f32x16;

#define NTP 16384
#define NTS 512
#define NT 16896
#define EPSF 1e-6f
#define NINF (-3.0e38f)

constexpr size_t OFF_WT_IN  = 0;
constexpr size_t OFF_WT_BRA = OFF_WT_IN + 12582912;
constexpr size_t OFF_WT_BRB = OFF_WT_BRA + 1048576;
constexpr size_t OFF_WT_OUT = OFF_WT_BRB + 1048576;
constexpr size_t OFF_WT_Q   = OFF_WT_OUT + 2097152;
constexpr size_t OFF_WT_PG  = OFF_WT_Q + 4194304;
constexpr size_t OFF_WT_PLE = OFF_WT_PG + 2097152;
constexpr size_t OFF_KEYS   = OFF_WT_PLE + 524288;
constexpr size_t OFF_H      = OFF_KEYS + 524288;
constexpr size_t OFF_BETA   = OFF_H + 34603008;
constexpr size_t OFF_GLOG   = OFF_BETA + 270336;
constexpr size_t OFF_DVEC   = OFF_GLOG + 270336;
constexpr size_t OFF_SSQO   = OFF_DVEC + 1048576;
constexpr size_t OFF_SSQ1   = OFF_SSQO + 2162688;
constexpr size_t OFF_SSQ3   = OFF_SSQ1 + 67584;
constexpr size_t OFF_R3     = OFF_SSQ3 + 67584;
constexpr size_t OFF_LOGF   = OFF_R3;
constexpr size_t OFF_VA     = OFF_R3 + 34603008;
constexpr size_t OFF_MRG    = OFF_R3;
constexpr size_t OFF_H2     = OFF_R3;
constexpr size_t OFF_R4     = OFF_R3 + 51904512;
constexpr size_t OFF_OGA    = OFF_R4;
constexpr size_t OFF_ZB     = OFF_R4 + 17301504;
constexpr size_t OFF_TOPS   = OFF_R4;
constexpr size_t OFF_TOPI   = OFF_R4 + 17301504;
constexpr size_t OFF_R5     = OFF_R4 + 34603008;
constexpr size_t OFF_O      = OFF_R5;
constexpr size_t OFF_H3     = OFF_R5;
constexpr size_t OFF_X1B    = OFF_R5;
constexpr size_t OFF_R6     = OFF_R5 + 34603008;
constexpr size_t OFF_QB     = OFF_R6;
constexpr size_t OFF_KT     = OFF_R6 + 33554432;
constexpr size_t OFF_VT     = OFF_R6 + 67108864;
constexpr size_t OFF_PN     = OFF_R6 + 100663296;
constexpr size_t OFF_EU     = OFF_R6;
constexpr size_t OFF_EV     = OFF_R6 + 16777216;
constexpr size_t OFF_BAR    = OFF_R6 + 134217728;
constexpr size_t OFF_MRG2   = OFF_BAR + 16384;
#define P4A_MAX_LEFT 64
constexpr size_t WS_TOTAL   = OFF_MRG2 + 64 * 32768;
static_assert(WS_TOTAL <= 330000000, "ws too big");

constexpr size_t OUT_Y   = 0;
constexpr size_t OUT_HP  = 17301504;
constexpr size_t OUT_DP  = 17825792;
constexpr size_t OUT_CP  = 18350080;
constexpr size_t OUT_HS  = 18386944;
constexpr size_t OUT_DS  = 26775552;
constexpr size_t OUT_CS  = 35164160;
constexpr size_t OUTB_RAW = 0;
constexpr size_t OUTB_QA  = 51904512;

struct Params {
  const float *x_prompt, *x_sample, *state_hgrn, *state_delta, *state_conv, *p_prompt, *p_sample,
      *lb_param, *g_mix, *w_in, *conv_w, *a_log, *dt_bias, *g_norm_a, *g_norm_b, *w_br_a, *w_br_b,
      *w_out, *g_ffn, *peer_wq, *peer_keys, *expert_u, *expert_v, *g_ple, *w_ple, *w_ple_gate, *g_final;
  float* out;
  char* ws;
};

#define SMEM_BYTES 145408
#ifndef PROBE
#define PROBE 0
#endif

typedef float f32x2_t __attribute__((ext_vector_type(2)));
typedef __bf16 bf16x2_t __attribute__((ext_vector_type(2)));
__device__ __forceinline__ unsigned pack2(float a, float b) {
  f32x2_t f = {a, b};
  bf16x2_t h = __builtin_convertvector(f, bf16x2_t);
  return __builtin_bit_cast(unsigned, h);
}
__device__ __forceinline__ u16 f2bf(float f) { return (u16)(pack2(f, f) & 0xffffu); }
__device__ __forceinline__ float bf2f(u16 h) { return __uint_as_float(((unsigned)h) << 16); }
__device__ __forceinline__ float bflo(unsigned u) { return __uint_as_float(u << 16); }
__device__ __forceinline__ float bfhi(unsigned u) { return __uint_as_float(u & 0xffff0000u); }
#define DPP_F(v, ctrl) __int_as_float(__builtin_amdgcn_update_dpp(0, __float_as_int(v), (ctrl), 0xF, 0xF, true))
__device__ __forceinline__ float dpp_row_sum16(float v) {
  v += __int_as_float(__builtin_amdgcn_update_dpp(0, __float_as_int(v), 0xB1, 0xF, 0xF, true));
  v += __int_as_float(__builtin_amdgcn_update_dpp(0, __float_as_int(v), 0x4E, 0xF, 0xF, true));
  v += __int_as_float(__builtin_amdgcn_update_dpp(0, __float_as_int(v), 0x141, 0xF, 0xF, true));
  v += __int_as_float(__builtin_amdgcn_update_dpp(0, __float_as_int(v), 0x140, 0xF, 0xF, true));
  return v;
}
__device__ __forceinline__ float sum32(float v) { v = dpp_row_sum16(v); v += __shfl_xor(v, 16); return v; }
__device__ __forceinline__ float wsum(float v) { v = dpp_row_sum16(v); v += __shfl_xor(v, 16); v += __shfl_xor(v, 32); return v; }
__device__ __forceinline__ float sigmoidf_(float x) { return __builtin_amdgcn_rcpf(1.f + __expf(-x)); }
__device__ __forceinline__ float siluf_(float x) { return x * __builtin_amdgcn_rcpf(1.f + __expf(-x)); }
__device__ __forceinline__ int rowmap(int e, int lane) { return (e & 3) + 8 * (e >> 2) + 4 * (lane >> 5); }
__device__ __forceinline__ f32x16 mfma16(bf16x8 a, bf16x8 b, f32x16 c) {
  return __builtin_amdgcn_mfma_f32_32x32x16_bf16(a, b, c, 0, 0, 0);
}
__device__ __forceinline__ f32x16 zero16() {
  f32x16 z;
#pragma unroll
  for (int e = 0; e < 16; e++) z[e] = 0.f;
  return z;
}
__device__ __forceinline__ const float* xrow(const Params& p, int tok) {
  return tok < NTP ? p.x_prompt + (size_t)tok * 1024 : p.x_sample + (size_t)(tok - NTP) * 1024;
}

__device__ __forceinline__ float transpose_reduce64(float (&v)[64], int lane) {
#pragma unroll
  for (int i = 0; i < 32; i++) { bool hi = lane & 32; float send = hi ? v[i] : v[i + 32]; float keep = hi ? v[i + 32] : v[i]; v[i] = keep + __shfl_xor(send, 32); }
#pragma unroll
  for (int i = 0; i < 16; i++) { bool hi = lane & 16; float send = hi ? v[i] : v[i + 16]; float keep = hi ? v[i + 16] : v[i]; v[i] = keep + __shfl_xor(send, 16); }
#pragma unroll
  for (int i = 0; i < 8; i++) { bool hi = lane & 8; float send = hi ? v[i] : v[i + 8]; float keep = hi ? v[i + 8] : v[i]; v[i] = keep + __shfl_xor(send, 8); }
#pragma unroll
  for (int i = 0; i < 4; i++) { bool hi = lane & 4; float send = hi ? v[i] : v[i + 4]; float keep = hi ? v[i + 4] : v[i]; v[i] = keep + __shfl_xor(send, 4); }
#pragma unroll
  for (int i = 0; i < 2; i++) { bool hi = lane & 2; float send = hi ? v[i] : v[i + 2]; float keep = hi ? v[i + 2] : v[i]; v[i] = keep + __shfl_xor(send, 2); }
  { bool hi = lane & 1; float send = hi ? v[0] : v[1]; float keep = hi ? v[1] : v[0]; v[0] = keep + __shfl_xor(send, 1); }
  return v[0];
}

struct LoadBf16 {
  const u16* A; int lda;
  struct Raw { uint4 v; };
  __device__ __forceinline__ void load(Raw& r, int row, int k) const { r.v = *(const uint4*)(A + (size_t)row * lda + k); }
  __device__ __forceinline__ uint4 cvt(const Raw& r, int row, int k) const { return r.v; }
};
struct LoadF32 {
  const float* A; int lda;
  struct Raw { float4 a, b; };
  __device__ __forceinline__ void load(Raw& r, int row, int k) const {
    const float4* q = (const float4*)(A + (size_t)row * lda + k); r.a = q[0]; r.b = q[1];
  }
  __device__ __forceinline__ uint4 cvt(const Raw& r, int row, int k) const {
    uint4 o; o.x = pack2(r.a.x, r.a.y); o.y = pack2(r.a.z, r.a.w); o.z = pack2(r.b.x, r.b.y); o.w = pack2(r.b.z, r.b.w); return o;
  }
};
struct LoadNormO {
  const u16* O; const u16* G; const float* rstdL; const float* gn;
  struct Raw { uint4 o, g; };
  __device__ __forceinline__ void load(Raw& r, int row, int k) const {
    r.o = *(const uint4*)(O + (size_t)row * 512 + k);
    r.g = *(const uint4*)(G + (size_t)row * 512 + k);
  }
  __device__ __forceinline__ uint4 cvt(const Raw& r, int row, int k) const {
    const float rs = rstdL[row * 4 + (k >> 7)];
    const float4* gq = (const float4*)(gn + (k & 127));
    float4 g0 = gq[0], g1 = gq[1];
    uint4 o;
    o.x = pack2(bflo(r.o.x) * rs * g0.x * bflo(r.g.x), bfhi(r.o.x) * rs * g0.y * bfhi(r.g.x));
    o.y = pack2(bflo(r.o.y) * rs * g0.z * bflo(r.g.y), bfhi(r.o.y) * rs * g0.w * bfhi(r.g.y));
    o.z = pack2(bflo(r.o.z) * rs * g1.x * bflo(r.g.z), bfhi(r.o.z) * rs * g1.y * bfhi(r.g.z));
    o.w = pack2(bflo(r.o.w) * rs * g1.z * bflo(r.g.w), bfhi(r.o.w) * rs * g1.w * bfhi(r.g.w));
    return o;
  }
};
struct LoadNormX {
  const float* X; const float* SSQ; const float* g; u16* Hout;
  struct Raw { float4 a, b; float s; };
  __device__ __forceinline__ void load(Raw& r, int row, int k) const {
    const float4* q = (const float4*)(X + (size_t)row * 1024 + k); r.a = q[0]; r.b = q[1]; r.s = SSQ[row];
  }
  __device__ __forceinline__ uint4 cvt(const Raw& r, int row, int k) const {
    float rs = rsqrtf(r.s * (1.f / 1024.f) + EPSF);
    const float4* gq = (const float4*)(g + k);
    float4 g0 = gq[0], g1 = gq[1];
    uint4 o;
    o.x = pack2(r.a.x * rs * g0.x, r.a.y * rs * g0.y); o.y = pack2(r.a.z * rs * g0.z, r.a.w * rs * g0.w);
    o.z = pack2(r.b.x * rs * g1.x, r.b.y * rs * g1.y); o.w = pack2(r.b.z * rs * g1.z, r.b.w * rs * g1.w);
    if (Hout) *(uint4*)(Hout + (size_t)row * 1024 + k) = o;
    return o;
  }
};

#define GM_LOAD1(kt_, j)                                                                                           \
  al.load(ar##j, lr + 16 * j, (kt_) * 128 + lk);                                                                   \
  br##j = *(const uint4*)(Bt + (size_t)(lr + 16 * j) * ldb + (kt_) * 128 + lk);
#define GM_LOAD(kt_) { GM_LOAD1(kt_, 0) GM_LOAD1(kt_, 1) GM_LOAD1(kt_, 2) GM_LOAD1(kt_, 3) GM_LOAD1(kt_, 4) GM_LOAD1(kt_, 5) GM_LOAD1(kt_, 6) GM_LOAD1(kt_, 7) }
#define GM_STORE1(kt_, An, Bn, j)                                                                                  \
  *(uint4*)&An[(lr + 16 * j) * 136 + lk] = al.cvt(ar##j, lr + 16 * j, (kt_) * 128 + lk);                           \
  *(uint4*)&Bn[(lr + 16 * j) * 136 + lk] = br##j;
#define GM_STORE(kt_, buf_)                                                                                        \
  {                                                                                                                \
    u16* An = As + (buf_) * 128 * 136; u16* Bn = Bs + (buf_) * 128 * 136;                                          \
    GM_STORE1(kt_, An, Bn, 0) GM_STORE1(kt_, An, Bn, 1) GM_STORE1(kt_, An, Bn, 2) GM_STORE1(kt_, An, Bn, 3)        \
    GM_STORE1(kt_, An, Bn, 4) GM_STORE1(kt_, An, Bn, 5) GM_STORE1(kt_, An, Bn, 6) GM_STORE1(kt_, An, Bn, 7)        \
  }
#define GM_FRAG(FA, FB, Ac, Bc, ks)                                                                               \
  FA##0 = *(const bf16x8*)&Ac[(wm * 64 + r) * 136 + (ks) * 16 + hh];                                               \
  FA##1 = *(const bf16x8*)&Ac[(wm * 64 + 32 + r) * 136 + (ks) * 16 + hh];                                          \
  FB##0 = *(const bf16x8*)&Bc[(wn * 64 + r) * 136 + (ks) * 16 + hh];                                               \
  FB##1 = *(const bf16x8*)&Bc[(wn * 64 + 32 + r) * 136 + (ks) * 16 + hh];
#define GM_MFMA4(FA, FB)                                                                                           \
  acc[0][0] = mfma16(FA##0, FB##0, acc[0][0]); acc[0][1] = mfma16(FA##0, FB##1, acc[0][1]);                        \
  acc[1][0] = mfma16(FA##1, FB##0, acc[1][0]); acc[1][1] = mfma16(FA##1, FB##1, acc[1][1]);
#define GM_COMPUTE(buf_)                                                                                           \
  {                                                                                                                \
    const u16* Ac = As + (buf_) * 128 * 136; const u16* Bc = Bs + (buf_) * 128 * 136;                              \
    bf16x8 fa0, fa1, fb0, fb1, ga0, ga1, gb0, gb1;                                                                 \
    GM_FRAG(fa, fb, Ac, Bc, 0)                                                                                     \
    _Pragma("unroll") for (int ks = 0; ks < 8; ks += 2) {                                                          \
      GM_FRAG(ga, gb, Ac, Bc, ks + 1)                                                                              \
      __builtin_amdgcn_sched_barrier(0);                                                                           \
      GM_MFMA4(fa, fb)                                                                                             \
      __builtin_amdgcn_sched_barrier(0);                                                                           \
      if (ks + 2 < 8) { GM_FRAG(fa, fb, Ac, Bc, ks + 2) }                                                          \
      __builtin_amdgcn_sched_barrier(0);                                                                           \
      GM_MFMA4(ga, gb)                                                                                             \
      __builtin_amdgcn_sched_barrier(0);                                                                           \
    }                                                                                                              \
  }
#define GEMM_LDS_BYTES 139264
template <class AL>
__device__ __forceinline__ void gemm_mainloop(f32x16 (&acc)[2][2], const AL& al, const u16* __restrict__ Bt, int ldb, int K, char* smem) {
  const int tid = threadIdx.x, lane = tid & 63, w = tid >> 6;
  const int wm = w >> 1, wn = w & 1;
  const int lr = tid >> 4, lk = (tid & 15) * 8;
  u16* As = (u16*)smem;
  u16* Bs = As + 2 * 128 * 136;
  typename AL::Raw ar0, ar1, ar2, ar3, ar4, ar5, ar6, ar7; uint4 br0, br1, br2, br3, br4, br5, br6, br7;
  const int KT = K >> 7;
  const int r = lane & 31, hh = (lane >> 5) * 8;
  __syncthreads();
  GM_LOAD(0)
  GM_STORE(0, 0)
  __syncthreads();
#pragma unroll 1
  for (int kt = 0; kt < KT; kt += 2) {
    if (kt + 1 < KT) { GM_LOAD(kt + 1) }
    GM_COMPUTE(0)
    if (kt + 1 < KT) { GM_STORE(kt + 1, 1) }
    __syncthreads();
    if (kt + 1 < KT) {
      if (kt + 2 < KT) { GM_LOAD(kt + 2) }
      GM_COMPUTE(1)
      if (kt + 2 < KT) { GM_STORE(kt + 2, 0) }
      __syncthreads();
    }
  }
}
#define GL_DMA(kt_, buf_)                                                                                          \
  {                                                                                                                \
    char* Ab_ = smem + (buf_) * 65536; char* Bb_ = Ab_ + 32768;                                                    \
    _Pragma("unroll") for (int i = 0; i < 8; i++) {                                                                \
      const int rowb = 4 * (i * 4 + w);                                                                            \
      const int row = rowb + (lane >> 4);                                                                          \
      const int c = (lane & 15) ^ (row & 15);                                                                      \
      __builtin_amdgcn_global_load_lds((const unsigned*)(A + (size_t)row * lda + (kt_) * 128 + c * 8), (unsigned*)(Ab_ + rowb * 256), 16, 0, 0); \
      __builtin_amdgcn_global_load_lds((const unsigned*)(Bt + (size_t)row * ldb + (kt_) * 128 + c * 8), (unsigned*)(Bb_ + rowb * 256), 16, 0, 0); \
    }                                                                                                              \
  }
#define GL_FRAG(FA, FB, Ac, Bc, ks)                                                                                \
  {                                                                                                                \
    const int co_ = (((ks) * 2 + hsel) ^ swz) * 8;                                                                 \
    FA##0 = *(const bf16x8*)&Ac[(wm * 64 + r) * 128 + co_];                                                        \
    FA##1 = *(const bf16x8*)&Ac[(wm * 64 + 32 + r) * 128 + co_];                                                   \
    FB##0 = *(const bf16x8*)&Bc[(wn * 64 + r) * 128 + co_];                                                        \
    FB##1 = *(const bf16x8*)&Bc[(wn * 64 + 32 + r) * 128 + co_];                                                   \
  }
#define GL_COMPUTE(buf_)                                                                                           \
  {                                                                                                                \
    const u16* Ac = (const u16*)(smem + (buf_) * 65536); const u16* Bc = Ac + 16384;                               \
    bf16x8 fa0, fa1, fb0, fb1, ga0, ga1, gb0, gb1;                                                                 \
    GL_FRAG(fa, fb, Ac, Bc, 0)                                                                                     \
    _Pragma("unroll") for (int ks = 0; ks < 8; ks += 2) {                                                          \
      GL_FRAG(ga, gb, Ac, Bc, ks + 1)                                                                              \
      __builtin_amdgcn_sched_barrier(0);                                                                           \
      GM_MFMA4(fa, fb)                                                                                             \
      __builtin_amdgcn_sched_barrier(0);                                                                           \
      if (ks + 2 < 8) { GL_FRAG(fa, fb, Ac, Bc, ks + 2) }                                                          \
      __builtin_amdgcn_sched_barrier(0);                                                                           \
      GM_MFMA4(ga, gb)                                                                                             \
      __builtin_amdgcn_sched_barrier(0);                                                                           \
    }                                                                                                              \
  }
__device__ __forceinline__ void gemm_mainloop_dma(f32x16 (&acc)[2][2], const u16* __restrict__ A, int lda, const u16* __restrict__ Bt, int ldb, int K, char* smem) {
  const int tid = threadIdx.x, lane = tid & 63, w = tid >> 6;
  const int wm = w >> 1, wn = w & 1;
  const int KT = K >> 7;
  const int r = lane & 31, hsel = lane >> 5, swz = lane & 15;
  __syncthreads();
  GL_DMA(0, 0)
  asm volatile("s_waitcnt vmcnt(0)" ::: "memory");
  __syncthreads();
#pragma unroll 1
  for (int kt = 0; kt < KT; kt += 2) {
    if (kt + 1 < KT) { GL_DMA(kt + 1, 1) }
    GL_COMPUTE(0)
    asm volatile("s_waitcnt vmcnt(0)" ::: "memory");
    __syncthreads();
    if (kt + 1 < KT) {
      if (kt + 2 < KT) { GL_DMA(kt + 2, 0) }
      GL_COMPUTE(1)
      asm volatile("s_waitcnt vmcnt(0)" ::: "memory");
      __syncthreads();
    }
  }
}
__device__ __forceinline__ void zero_acc(f32x16 (&acc)[2][2]) {
#pragma unroll
  for (int i = 0; i < 2; i++)
#pragma unroll
    for (int j = 0; j < 2; j++) acc[i][j] = zero16();
}

__device__ __forceinline__ void transpose_tile(const float* __restrict__ src, int ldn, int K, u16* __restrict__ dst, int k0, int ns0, int nd0, char* smem, const float* __restrict__ kscale = nullptr) {
  float* t = (float*)smem;
  const int tid = threadIdx.x;
  __syncthreads();
#pragma unroll
  for (int i = 0; i < 4; i++) {
    int idx = tid + 256 * i; int rr = idx >> 4, c4 = (idx & 15) * 4;
    float4 v = *(const float4*)(src + (size_t)(k0 + rr) * ldn + ns0 + c4);
    if (kscale) { const float sc = kscale[k0 + rr]; v.x *= sc; v.y *= sc; v.z *= sc; v.w *= sc; }
    t[c4 * 65 + rr] = v.x; t[(c4 + 1) * 65 + rr] = v.y; t[(c4 + 2) * 65 + rr] = v.z; t[(c4 + 3) * 65 + rr] = v.w;
  }
  __syncthreads();
  const int n = tid >> 2, kq = (tid & 3) * 16;
  unsigned pk[8];
#pragma unroll
  for (int i = 0; i < 8; i++) pk[i] = pack2(t[n * 65 + kq + 2 * i], t[n * 65 + kq + 2 * i + 1]);
  uint4* d = (uint4*)(dst + (size_t)(nd0 + n) * K + k0 + kq);
  d[0] = make_uint4(pk[0], pk[1], pk[2], pk[3]);
  d[1] = make_uint4(pk[4], pk[5], pk[6], pk[7]);
}
__device__ __forceinline__ void convert_item4(const float* __restrict__ src, u16* __restrict__ dst, size_t item) {
  size_t base = item * 8192 + (size_t)threadIdx.x * 8;
  float4 a[4], b[4];
#pragma unroll
  for (int i = 0; i < 4; i++) { const float4* q = (const float4*)(src + base + i * 2048); a[i] = q[0]; b[i] = q[1]; }
#pragma unroll
  for (int i = 0; i < 4; i++)
    *(uint4*)(dst + base + i * 2048) = make_uint4(pack2(a[i].x, a[i].y), pack2(a[i].z, a[i].w), pack2(b[i].x, b[i].y), pack2(b[i].z, b[i].w));
}
typedef float float2v __attribute__((ext_vector_type(2)));
#define EU_SCALE 64.f
#define EV_SCALE 16.f
__device__ __forceinline__ void convert_item_fp8(const float* __restrict__ src, unsigned char* __restrict__ dst, size_t item, float scale) {
  size_t base = item * 8192 + (size_t)threadIdx.x * 16;
  float4 a[2][4];
#pragma unroll
  for (int i = 0; i < 2; i++) {
    const float4* q = (const float4*)(src + base + i * 4096);
#pragma unroll
    for (int j = 0; j < 4; j++) a[i][j] = q[j];
  }
#pragma unroll
  for (int i = 0; i < 2; i++) {
    unsigned o[4];
#pragma unroll
    for (int j = 0; j < 4; j++) {
      int pk = __builtin_amdgcn_cvt_pk_fp8_f32(a[i][j].x * scale, a[i][j].y * scale, 0, false);
      pk = __builtin_amdgcn_cvt_pk_fp8_f32(a[i][j].z * scale, a[i][j].w * scale, pk, true);
      o[j] = (unsigned)pk;
    }
    *(uint4*)(dst + base + i * 4096) = make_uint4(o[0], o[1], o[2], o[3]);
  }
}
__device__ __forceinline__ void convert_item(const float* __restrict__ src, u16* __restrict__ dst, size_t item) {
  size_t base = item * 2048 + (size_t)threadIdx.x * 8;
  const float4* q = (const float4*)(src + base);
  float4 a = q[0], b = q[1];
  *(uint4*)(dst + base) = make_uint4(pack2(a.x, a.y), pack2(a.z, a.w), pack2(b.x, b.y), pack2(b.z, b.w));
}

struct TDesc { const float* src; u16* dst; const float* ks; int ldn, K, k0, ns0, nd0; };
__device__ __forceinline__ void transpose_pair(const TDesc& a, const TDesc& b, const bool hasb, char* smem) {
  float* t0 = (float*)smem; float* t1 = t0 + 64 * 65;
  const int tid = threadIdx.x;
  __syncthreads();
  float4 va[4], vb[4];
#pragma unroll
  for (int i = 0; i < 4; i++) {
    const int idx = tid + 256 * i, rr = idx >> 4, c4 = (idx & 15) * 4;
    va[i] = *(const float4*)(a.src + (size_t)(a.k0 + rr) * a.ldn + a.ns0 + c4);
    if (hasb) vb[i] = *(const float4*)(b.src + (size_t)(b.k0 + rr) * b.ldn + b.ns0 + c4);
  }
#pragma unroll
  for (int i = 0; i < 4; i++) {
    const int idx = tid + 256 * i, rr = idx >> 4, c4 = (idx & 15) * 4;
    float4 v = va[i];
    if (a.ks) { const float sc = a.ks[a.k0 + rr]; v.x *= sc; v.y *= sc; v.z *= sc; v.w *= sc; }
    t0[c4 * 65 + rr] = v.x; t0[(c4 + 1) * 65 + rr] = v.y; t0[(c4 + 2) * 65 + rr] = v.z; t0[(c4 + 3) * 65 + rr] = v.w;
    if (hasb) {
      float4 u = vb[i];
      if (b.ks) { const float sc = b.ks[b.k0 + rr]; u.x *= sc; u.y *= sc; u.z *= sc; u.w *= sc; }
      t1[c4 * 65 + rr] = u.x; t1[(c4 + 1) * 65 + rr] = u.y; t1[(c4 + 2) * 65 + rr] = u.z; t1[(c4 + 3) * 65 + rr] = u.w;
    }
  }
  __syncthreads();
  const int n = tid >> 2, kq = (tid & 3) * 16;
  {
    unsigned pk[8];
#pragma unroll
    for (int i = 0; i < 8; i++) pk[i] = pack2(t0[n * 65 + kq + 2 * i], t0[n * 65 + kq + 2 * i + 1]);
    uint4* d = (uint4*)(a.dst + (size_t)(a.nd0 + n) * a.K + a.k0 + kq);
    d[0] = make_uint4(pk[0], pk[1], pk[2], pk[3]); d[1] = make_uint4(pk[4], pk[5], pk[6], pk[7]);
  }
  if (hasb) {
    unsigned pk[8];
#pragma unroll
    for (int i = 0; i < 8; i++) pk[i] = pack2(t1[n * 65 + kq + 2 * i], t1[n * 65 + kq + 2 * i + 1]);
    uint4* d = (uint4*)(b.dst + (size_t)(b.nd0 + n) * b.K + b.k0 + kq);
    d[0] = make_uint4(pk[0], pk[1], pk[2], pk[3]); d[1] = make_uint4(pk[4], pk[5], pk[6], pk[7]);
  }
}
__device__ __forceinline__ void phase0(const Params& p, char* smem) {
  const int tid = threadIdx.x, lane = tid & 63, w = tid >> 6;
  char* ws = p.ws;
  const int N_IN = 1536, N_BRA = 128, N_BRB = 128, N_OUT = 256, N_Q = 512, N_PG = 256, N_PLE = 64, N_KEYS = 128;
  const int T0 = N_IN, T1 = T0 + N_BRA, T2 = T1 + N_BRB, T3 = T2 + N_OUT, T4 = T3 + N_Q, T5 = T4 + N_PG, T6 = T5 + N_PLE, T7 = T6 + N_KEYS;
  auto tdesc = [&](int it) -> TDesc {
    TDesc d; d.ks = nullptr;
    if (it < T0) { int kt = it & 15, nt = it >> 4; int nd0 = nt * 64; d.src = p.w_in; d.ldn = 6152; d.K = 1024; d.dst = (u16*)(ws + OFF_WT_IN); d.k0 = kt * 64; d.nd0 = nd0; d.ns0 = nd0 < 4096 ? nd0 : nd0 + 8; }
    else if (it < T1) { int i = it - T0; int kt = i & 7, nt = i >> 3; d.src = p.w_br_a; d.ldn = 1024; d.K = 512; d.dst = (u16*)(ws + OFF_WT_BRA); d.k0 = kt * 64; d.ns0 = d.nd0 = nt * 64; }
    else if (it < T2) { int i = it - T1; int kt = i & 7, nt = i >> 3; d.src = p.w_br_b; d.ldn = 1024; d.K = 512; d.dst = (u16*)(ws + OFF_WT_BRB); d.k0 = kt * 64; d.ns0 = d.nd0 = nt * 64; }
    else if (it < T3) { int i = it - T2; int kt = i & 15, nt = i >> 4; d.src = p.w_out; d.ldn = 1024; d.K = 1024; d.dst = (u16*)(ws + OFF_WT_OUT); d.k0 = kt * 64; d.ns0 = d.nd0 = nt * 64; }
    else if (it < T4) { int i = it - T3; int kt = i & 15, nt = i >> 4; d.src = p.peer_wq; d.ldn = 2048; d.K = 1024; d.dst = (u16*)(ws + OFF_WT_Q); d.k0 = kt * 64; d.ns0 = d.nd0 = nt * 64; d.ks = p.g_ffn; }
    else if (it < T5) { int i = it - T4; int kt = i & 15, nt = i >> 4; d.src = p.w_ple_gate; d.ldn = 1024; d.K = 1024; d.dst = (u16*)(ws + OFF_WT_PG); d.k0 = kt * 64; d.ns0 = d.nd0 = nt * 64; }
    else { int i = it - T5; int kt = i & 3, nt = i >> 2; d.src = p.w_ple; d.ldn = 1024; d.K = 256; d.dst = (u16*)(ws + OFF_WT_PLE); d.k0 = kt * 64; d.ns0 = d.nd0 = nt * 64; }
    return d;
  };
  for (int it = blockIdx.x; it < T6; it += 2 * gridDim.x) {
    const int it2 = it + (int)gridDim.x;
    const bool hasb = it2 < T6;
    const TDesc da = tdesc(it), db = tdesc(hasb ? it2 : it);
    transpose_pair(da, db, hasb, smem);
  }
  for (int it = T6 + blockIdx.x; it < T7; it += gridDim.x) convert_item(p.peer_keys, (u16*)(ws + OFF_KEYS), it - T6);
  __syncthreads();
  float* w8 = (float*)smem;
  for (int i = tid; i < 2048; i += 256) {
    int k = i >> 1, half = i & 1;
    *(float4*)&w8[k * 8 + half * 4] = *(const float4*)(p.w_in + (size_t)k * 6152 + 4096 + half * 4);
  }
  __syncthreads();
  u16* H = (u16*)(ws + OFF_H);
  float* BETA = (float*)(ws + OFF_BETA); float* GLOG = (float*)(ws + OFF_GLOG);
  float* SSQ1 = (float*)(ws + OFF_SSQ1); float* SSQ3 = (float*)(ws + OFF_SSQ3);
  for (int it = blockIdx.x; it < NT / 4; it += gridDim.x) {
    const int row = it * 4 + w;
    const float* xr = xrow(p, row);
    float4 xv[4]; float ss = 0.f;
#pragma unroll
    for (int i = 0; i < 4; i++) { xv[i] = *(const float4*)(xr + i * 256 + lane * 4); ss += xv[i].x * xv[i].x + xv[i].y * xv[i].y + xv[i].z * xv[i].z + xv[i].w * xv[i].w; }
    ss = wsum(ss);
    const float rs = rsqrtf(ss * (1.f / 1024.f) + EPSF);
    float d8[8];
#pragma unroll
    for (int j = 0; j < 8; j++) d8[j] = 0.f;
#pragma unroll
    for (int i = 0; i < 4; i++) {
      const int k = i * 256 + lane * 4;
      float4 g = *(const float4*)(p.g_mix + k);
      float hv[4] = {xv[i].x * rs * g.x, xv[i].y * rs * g.y, xv[i].z * rs * g.z, xv[i].w * rs * g.w};
      *(uint2*)(H + (size_t)row * 1024 + k) = make_uint2(pack2(hv[0], hv[1]), pack2(hv[2], hv[3]));
#pragma unroll
      for (int q = 0; q < 4; q++) {
        float4 wa = *(const float4*)&w8[(k + q) * 8], wb = *(const float4*)&w8[(k + q) * 8 + 4];
        d8[0] += hv[q] * wa.x; d8[1] += hv[q] * wa.y; d8[2] += hv[q] * wa.z; d8[3] += hv[q] * wa.w;
        d8[4] += hv[q] * wb.x; d8[5] += hv[q] * wb.y; d8[6] += hv[q] * wb.z; d8[7] += hv[q] * wb.w;
      }
    }
#pragma unroll
    for (int j = 0; j < 8; j++) d8[j] = wsum(d8[j]);
    if (lane < 4) {
      float bb = lane == 0 ? d8[0] : lane == 1 ? d8[1] : lane == 2 ? d8[2] : d8[3];
      float ab = lane == 0 ? d8[4] : lane == 1 ? d8[5] : lane == 2 ? d8[6] : d8[7];
      BETA[row * 4 + lane] = sigmoidf_(bb);
      float z = ab + p.dt_bias[lane];
      float sp = z > 20.f ? z : log1pf(expf(z));
      GLOG[row * 4 + lane] = -expf(p.a_log[lane]) * sp;
    }
    if (lane == 0) { SSQ1[row] = 0.f; SSQ3[row] = 0.f; }
  }
}

__device__ __forceinline__ void phase1(const Params& p, char* smem) {
  const int tid = threadIdx.x, lane = tid & 63, w = tid >> 6, wm = w >> 1, wn = w & 1;
  char* ws = p.ws;
  const u16* H = (const u16*)(ws + OFF_H);
  const u16* WT = (const u16*)(ws + OFF_WT_IN);
  u16* QA = (u16*)((char*)p.out + OUTB_QA); u16* RAW = (u16*)((char*)p.out + OUTB_RAW);
  float* LOGF = (float*)(ws + OFF_LOGF); u16* VA = (u16*)(ws + OFF_VA);
  u16* OGA = (u16*)(ws + OFF_OGA); u16* ZB = (u16*)(ws + OFF_ZB);
  const int NTILES = 132 * 32;
  for (int it = blockIdx.x; it < NTILES; it += gridDim.x) {
    const int nt = it & 31, mt = it >> 5;
    const int m0 = mt * 128, n0 = nt * 128;
    f32x16 acc[2][2]; zero_acc(acc);
    gemm_mainloop_dma(acc, H + (size_t)m0 * 1024, 1024, WT + (size_t)n0 * 1024, 1024, 1024, smem);
    const int seg = nt >> 2, cb = (nt & 3) * 128;
    if (seg == 1) {
      float* T32 = (float*)smem;
#pragma unroll
      for (int i = 0; i < 2; i++)
#pragma unroll
        for (int j = 0; j < 2; j++) {
          const int cl = wn * 64 + j * 32 + (lane & 31);
          const float p0 = p.lb_param[cb + cl], p1 = p.lb_param[512 + cb + cl];
          const float lb = 1.f / (1.f + __expf(p1 - p0));
#pragma unroll
          for (int e = 0; e < 16; e++) {
            const float f = lb + (1.f - lb) * sigmoidf_(acc[i][j][e]);
            T32[(wm * 64 + i * 32 + rowmap(e, lane)) * 132 + cl] = __logf(f);
          }
        }
      __syncthreads();
#pragma unroll
      for (int q = 0; q < 16; q++) {
        const int idx = tid + 256 * q, row = idx >> 5, c4 = idx & 31;
        *(float4*)(LOGF + (size_t)(m0 + row) * 512 + cb + c4 * 4) = *(const float4*)&T32[row * 132 + c4 * 4];
      }
    } else {
      u16* T = (u16*)smem;
      const bool act = (seg == 0 || seg == 3 || seg == 7);
#pragma unroll
      for (int i = 0; i < 2; i++)
#pragma unroll
        for (int j = 0; j < 2; j++) {
          const int cl = wn * 64 + j * 32 + (lane & 31);
#pragma unroll
          for (int e = 0; e < 16; e++) {
            const float v = acc[i][j][e];
            const int rl = wm * 64 + i * 32 + rowmap(e, lane);
            T[rl * 136 + cl] = f2bf(act ? siluf_(v) : v);
            if (seg >= 4 && seg <= 6) {
              const int row = m0 + rl; const int ch = (seg - 4) * 512 + cb + cl;
              if (row < NTP) { int t = row & 2047; if (t >= 2045) p.out[OUT_CP + ((size_t)(row >> 11) * 3 + (t - 2045)) * 1536 + ch] = v; }
              else { int rs = row - NTP; int t = rs & 3; if (t >= 1) p.out[OUT_CS + ((size_t)(rs >> 2) * 3 + (t - 1)) * 1536 + ch] = v; }
            }
          }
        }
      __syncthreads();
      u16* dst; int ld;
      if (seg == 0) { dst = QA + cb; ld = 512; }
      else if (seg == 2) { dst = VA + cb; ld = 512; }
      else if (seg == 3) { dst = OGA + cb; ld = 512; }
      else if (seg == 7) { dst = ZB + cb; ld = 512; }
      else { dst = RAW + (seg - 4) * 512 + cb; ld = 1536; }
#pragma unroll
      for (int q = 0; q < 8; q++) {
        const int idx = tid + 256 * q, row = idx >> 4, c8 = idx & 15;
        *(uint4*)(dst + (size_t)(m0 + row) * ld + c8 * 8) = *(const uint4*)&T[row * 136 + c8 * 8];
      }
    }
  }
}

__device__ __forceinline__ void gdn_chunk_item(const Params& p, int item, char* smem) {
  const int tid = threadIdx.x, lane = tid & 63, w = tid >> 6;
  const int n = item & 31, bh = item >> 5, h = bh & 3, b = bh >> 2;
  const int tok0 = b * 2048 + n * 64;
  const int ci = 1024 + item;
  char* ws = p.ws;
  u16* Qs = (u16*)smem;
  u16* Ks = (u16*)(smem + 18432);
  float* Ls = (float*)(smem + 36864);
  u16* QKs = (u16*)(smem + 55296);
  float* sm_g = (float*)(smem + 64512);
  float* sm_bt = sm_g + 64; float* sm_gc = sm_g + 128; float* sm_eg = sm_g + 192; float* sm_red = sm_g + 256;
  float* Xs = (float*)(smem + 66560);
  const u16* RAW = (const u16*)((const char*)p.out + OUTB_RAW);
  u16* QB = (u16*)(ws + OFF_QB) + (size_t)ci * 8192;
  u16* KT = (u16*)(ws + OFF_KT) + (size_t)ci * 8192;
  u16* VT = (u16*)(ws + OFF_VT) + (size_t)ci * 8192;
  u16* PN = (u16*)(ws + OFF_PN) + (size_t)item * 16384;
  u16* Oo = (u16*)(ws + OFF_O) + (size_t)NT * 512;
  __syncthreads();
  if (tid < 64) {
    float g = ((const float*)(ws + OFF_GLOG))[(size_t)(tok0 + tid) * 4 + h];
    float bt = ((const float*)(ws + OFF_BETA))[(size_t)(tok0 + tid) * 4 + h];
    float c = g;
#pragma unroll
    for (int o = 1; o < 64; o <<= 1) { float t = __shfl_up(c, o); if (lane >= o) c += t; }
    sm_g[tid] = g; sm_bt[tid] = bt; sm_gc[tid] = c; sm_eg[tid] = __expf(c);
  }
  __syncthreads();
  const float gl = sm_gc[63];
  const int type = tid >> 7, c = tid & 127;
  float val[64];
  float vv[64];
  {
    u16* tile = (u16*)Xs;
    for (int i = tid; i < 67 * 48; i += 256) {
      const int row = i / 48, rem = i - row * 48, seg = rem >> 4, c8 = rem & 15;
      uint4 v4 = make_uint4(0, 0, 0, 0);
      if (n > 0 || row >= 3) v4 = *(const uint4*)(RAW + (size_t)(tok0 - 3 + row) * 1536 + seg * 512 + h * 128 + c8 * 8);
      *(uint4*)&tile[row * 384 + seg * 128 + c8 * 8] = v4;
    }
    __syncthreads();
    {
      const int col = type * 512 + h * 128 + c;
      const float w0 = p.conv_w[col], w1 = p.conv_w[1536 + col], w2 = p.conv_w[3072 + col], w3 = p.conv_w[4608 + col];
      const u16* tp = tile + type * 128 + c;
      float x0 = bf2f(tp[0]), x1 = bf2f(tp[384]), x2 = bf2f(tp[768]);
#pragma unroll
      for (int t = 0; t < 64; t++) {
        float x3 = bf2f(tp[(t + 3) * 384]);
        float cv = x0 * w0 + x1 * w1 + x2 * w2 + x3 * w3;
        val[t] = siluf_(cv);
        x0 = x1; x1 = x2; x2 = x3;
      }
    }
    float sq[64];
#pragma unroll
    for (int t = 0; t < 64; t++) sq[t] = val[t] * val[t];
    float part = transpose_reduce64(sq, lane);
    sm_red[(type * 2 + (w & 1)) * 64 + lane] = part;
  }
  __syncthreads();
  {
    u16* Xs = type ? Ks : Qs;
    const float sc = type ? 1.f : 0.08838834764831845f;
#pragma unroll
    for (int t = 0; t < 64; t++) {
      float rn = rsqrtf(sm_red[(type * 2) * 64 + t] + sm_red[(type * 2 + 1) * 64 + t] + EPSF) * sc;
      val[t] *= rn;
      Xs[t * 136 + c] = f2bf(val[t]);
    }
  }
  {
    const u16* tile = (const u16*)Xs;
  if (type == 0) {
    const int col = 1024 + h * 128 + c;
    const float w0 = p.conv_w[col], w1 = p.conv_w[1536 + col], w2 = p.conv_w[3072 + col], w3 = p.conv_w[4608 + col];
    const u16* tp = tile + 256 + c;
    float x0 = bf2f(tp[0]), x1 = bf2f(tp[384]), x2 = bf2f(tp[768]);
#pragma unroll
    for (int t = 0; t < 64; t++) {
      float x3 = bf2f(tp[(t + 3) * 384]);
      float cv = x0 * w0 + x1 * w1 + x2 * w2 + x3 * w3;
      vv[t] = siluf_(cv) * sm_bt[t];
      x0 = x1; x1 = x2; x2 = x3;
    }
  }
  }
  __syncthreads();
#pragma unroll
  for (int q = 0; q < 4; q++) {
    const int idx = tid + 256 * q, row = idx >> 4, c8 = idx & 15;
    const uint4 v4 = *(const uint4*)&Qs[row * 136 + c8 * 8];
    const float eg = sm_eg[row];
    *(uint4*)&QB[row * 128 + c8 * 8] = make_uint4(pack2(bflo(v4.x) * eg, bfhi(v4.x) * eg), pack2(bflo(v4.y) * eg, bfhi(v4.y) * eg),
                                                   pack2(bflo(v4.z) * eg, bfhi(v4.z) * eg), pack2(bflo(v4.w) * eg, bfhi(v4.w) * eg));
  }
  {
    const int mi = w >> 1, ni = w & 1, r = lane & 31, hh = (lane >> 5) * 8;
    f32x16 kk = zero16(), qk = zero16();
#pragma unroll
    for (int ks = 0; ks < 8; ks++) {
      bf16x8 ak = *(const bf16x8*)&Ks[(mi * 32 + r) * 136 + ks * 16 + hh];
      bf16x8 bk = *(const bf16x8*)&Ks[(ni * 32 + r) * 136 + ks * 16 + hh];
      bf16x8 aq = *(const bf16x8*)&Qs[(mi * 32 + r) * 136 + ks * 16 + hh];
      kk = mfma16(ak, bk, kk); qk = mfma16(aq, bk, qk);
    }
    const int s = ni * 32 + r; const float gcs = sm_gc[s];
#pragma unroll
    for (int e = 0; e < 16; e++) {
      const int t = mi * 32 + rowmap(e, lane);
      float gam = (s <= t) ? __expf(sm_gc[t] - gcs) : 0.f;
      Ls[t * 68 + s] = (s < t) ? sm_bt[t] * gam * kk[e] : 0.f;
      QKs[t * 72 + s] = f2bf(qk[e] * gam);
    }
  }
  __syncthreads();
  if (type == 1) {
    u16* kdT = Qs;
    unsigned pk[32];
#pragma unroll
    for (int s2 = 0; s2 < 32; s2++) pk[s2] = pack2(val[2 * s2] * __expf(gl - sm_gc[2 * s2]), val[2 * s2 + 1] * __expf(gl - sm_gc[2 * s2 + 1]));
#pragma unroll
    for (int q = 0; q < 8; q++) {
      uint4 v4 = make_uint4(pk[4 * q], pk[4 * q + 1], pk[4 * q + 2], pk[4 * q + 3]);
      *(uint4*)&kdT[c * 72 + q * 8] = v4;
      *(uint4*)&KT[c * 64 + q * 8] = v4;
    }
#pragma unroll
    for (int t = 0; t < 64; t++) Xs[t * 256 + tid] = sm_bt[t] * sm_eg[t] * val[t];
  } else {
#pragma unroll
    for (int t = 0; t < 64; t++) Xs[t * 256 + tid] = vv[t];
  }
  {
    float* xc = Xs + tid;
#pragma unroll 1
    for (int b4 = 0; b4 < 16; b4++) {
      const int t0 = b4 * 4;
      float a0 = xc[t0 * 256], a1 = xc[(t0 + 1) * 256], a2 = xc[(t0 + 2) * 256], a3 = xc[(t0 + 3) * 256];
      const float* l0p = Ls + t0 * 68;
#pragma unroll 2
      for (int sg = 0; sg < b4; sg++) {
        const float4 l0 = *(const float4*)&l0p[sg * 4], l1 = *(const float4*)&l0p[68 + sg * 4];
        const float4 l2 = *(const float4*)&l0p[136 + sg * 4], l3 = *(const float4*)&l0p[204 + sg * 4];
        const float* xp = xc + sg * 1024;
        const float x0 = xp[0], x1 = xp[256], x2 = xp[512], x3 = xp[768];
        a0 -= l0.x * x0; a0 -= l0.y * x1; a0 -= l0.z * x2; a0 -= l0.w * x3;
        a1 -= l1.x * x0; a1 -= l1.y * x1; a1 -= l1.z * x2; a1 -= l1.w * x3;
        a2 -= l2.x * x0; a2 -= l2.y * x1; a2 -= l2.z * x2; a2 -= l2.w * x3;
        a3 -= l3.x * x0; a3 -= l3.y * x1; a3 -= l3.z * x2; a3 -= l3.w * x3;
      }
      const float4 d1 = *(const float4*)&l0p[68 + t0], d2 = *(const float4*)&l0p[136 + t0], d3 = *(const float4*)&l0p[204 + t0];
      a1 -= d1.x * a0;
      a2 -= d2.x * a0; a2 -= d2.y * a1;
      a3 -= d3.x * a0; a3 -= d3.y * a1; a3 -= d3.z * a2;
      xc[t0 * 256] = a0; xc[(t0 + 1) * 256] = a1; xc[(t0 + 2) * 256] = a2; xc[(t0 + 3) * 256] = a3;
    }
#pragma unroll
    for (int t = 0; t < 64; t++) val[t] = xc[t * 256];
  }
  __syncthreads();
  {
    u16* dstL = type == 0 ? (u16*)Ls : Ks;
#pragma unroll
    for (int q = 0; q < 8; q++) {
      uint4 v4 = make_uint4(pack2(val[8 * q], val[8 * q + 1]), pack2(val[8 * q + 2], val[8 * q + 3]), pack2(val[8 * q + 4], val[8 * q + 5]), pack2(val[8 * q + 6], val[8 * q + 7]));
      *(uint4*)&dstL[c * 72 + q * 8] = v4;
      if (type == 0) *(uint4*)&VT[c * 64 + q * 8] = v4;
    }
  }
  __syncthreads();
  {
    const u16* U0T = (const u16*)Ls; const u16* WTl = Ks; const u16* kdT = Qs;
    u16* O0T = (u16*)Xs; u16* QWT = O0T + 64 * 136; u16* PNT = QWT + 64 * 136;
    const int r = lane & 31, hh = (lane >> 5) * 8;
    const int mi = w & 1, ni0 = (w >> 1) * 2;
#pragma unroll
    for (int jj = 0; jj < 2; jj++) {
      const int ni = ni0 + jj;
      f32x16 o0 = zero16(), qw = zero16();
#pragma unroll
      for (int ks = 0; ks < 4; ks++) {
        bf16x8 a = *(const bf16x8*)&QKs[(mi * 32 + r) * 72 + ks * 16 + hh];
        bf16x8 bu = *(const bf16x8*)&U0T[(ni * 32 + r) * 72 + ks * 16 + hh];
        bf16x8 bw = *(const bf16x8*)&WTl[(ni * 32 + r) * 72 + ks * 16 + hh];
        o0 = mfma16(a, bu, o0); qw = mfma16(a, bw, qw);
      }
      const int col = ni * 32 + r;
#pragma unroll
      for (int e = 0; e < 16; e++) {
        const int t = mi * 32 + rowmap(e, lane);
        O0T[t * 136 + col] = f2bf(o0[e]);
        QWT[t * 136 + col] = f2bf(qw[e]);
      }
    }
#pragma unroll
    for (int ni = 0; ni < 4; ni++) {
      f32x16 pn = zero16();
#pragma unroll
      for (int ks = 0; ks < 4; ks++) {
        bf16x8 a = *(const bf16x8*)&kdT[(w * 32 + r) * 72 + ks * 16 + hh];
        bf16x8 bw = *(const bf16x8*)&WTl[(ni * 32 + r) * 72 + ks * 16 + hh];
        pn = mfma16(a, bw, pn);
      }
#pragma unroll
      for (int e = 0; e < 16; e++) PNT[(w * 32 + rowmap(e, lane)) * 136 + ni * 32 + r] = f2bf(-pn[e]);
    }
    if (tid < 128) ((float*)(ws + OFF_DVEC))[(size_t)ci * 128 + tid] = __expf(gl);
    __syncthreads();
#pragma unroll
    for (int q = 0; q < 4; q++) {
      const int idx = tid + 256 * q, row = idx >> 4, c8 = idx & 15;
      *(uint4*)&Oo[(size_t)(tok0 + row) * 512 + h * 128 + c8 * 8] = *(const uint4*)&O0T[row * 136 + c8 * 8];
      const uint4 a4 = *(const uint4*)&QB[row * 128 + c8 * 8];
      const uint4 w4 = *(const uint4*)&QWT[row * 136 + c8 * 8];
      *(uint4*)&QB[row * 128 + c8 * 8] = make_uint4(pack2(bflo(a4.x) - bflo(w4.x), bfhi(a4.x) - bfhi(w4.x)), pack2(bflo(a4.y) - bflo(w4.y), bfhi(a4.y) - bfhi(w4.y)),
                                                     pack2(bflo(a4.z) - bflo(w4.z), bfhi(a4.z) - bfhi(w4.z)), pack2(bflo(a4.w) - bflo(w4.w), bfhi(a4.w) - bfhi(w4.w)));
    }
#pragma unroll
    for (int q = 0; q < 8; q++) {
      const int idx = tid + 256 * q, row = idx >> 4, c8 = idx & 15;
      *(uint4*)&PN[row * 128 + c8 * 8] = *(const uint4*)&PNT[row * 136 + c8 * 8];
    }
  }
}

__device__ __forceinline__ void hgrn_chunk_item(const Params& p, int item, char* smem) {
  const int tid = threadIdx.x, lane = tid & 63, w = tid >> 6;
  const int n = item & 31, bh = item >> 5, h = bh & 3, b = bh >> 2;
  const int tok0 = b * 2048 + n * 64;
  const int ci = item;
  char* ws = p.ws;
  u16* Qt = (u16*)smem;
  u16* Kt = (u16*)(smem + 17408);
  u16* ATT = (u16*)(smem + 34816);
  u16* VTs = (u16*)(smem + 44032);
  const float* LOGF = (const float*)(ws + OFF_LOGF);
  const u16* QA = (const u16*)((const char*)p.out + OUTB_QA);
  const u16* VA = (const u16*)(ws + OFF_VA);
  u16* QB = (u16*)(ws + OFF_QB) + (size_t)ci * 8192;
  u16* KT = (u16*)(ws + OFF_KT) + (size_t)ci * 8192;
  u16* VT = (u16*)(ws + OFF_VT) + (size_t)ci * 8192;
  u16* Oo = (u16*)(ws + OFF_O);
  __syncthreads();
  const int d = tid & 127, half = tid >> 7;
  const int colb = h * 128 + d;
  float* LFs = (float*)(smem + 62464);
  u16* QAs = (u16*)(smem + 95232);
  u16* VAs = (u16*)(smem + 111616);
  u16* OT = (u16*)LFs;
  {
#pragma unroll
    for (int q = 0; q < 8; q++) {
      const int i = tid + 256 * q; const int row = i >> 5, c4 = i & 31;
      *(float4*)&LFs[row * 128 + c4 * 4] = *(const float4*)(LOGF + (size_t)(tok0 + row) * 512 + h * 128 + c4 * 4);
    }
#pragma unroll
    for (int q = 0; q < 4; q++) {
      const int i = tid + 256 * q; const int row = i >> 4, c8 = i & 15;
      *(uint4*)&QAs[row * 128 + c8 * 8] = *(const uint4*)(QA + (size_t)(tok0 + row) * 512 + h * 128 + c8 * 8);
      *(uint4*)&VAs[row * 128 + c8 * 8] = *(const uint4*)(VA + (size_t)(tok0 + row) * 512 + h * 128 + c8 * 8);
    }
  }
  __syncthreads();
  float bc[64];
  {
    float run = 0.f;
#pragma unroll
    for (int t = 0; t < 64; t++) { run += LFs[t * 128 + d]; bc[t] = run; }
  }
  const float rref = bc[31], bl = bc[63];
  if (half == 0) {
#pragma unroll
    for (int t = 0; t < 64; t++) {
      float q = bf2f(QAs[t * 128 + d]);
      Qt[t * 136 + d] = f2bf(q * __expf(bc[t] - rref));
      QAs[t * 128 + d] = f2bf(q * __expf(bc[t]));
    }
    ((float*)(ws + OFF_DVEC))[(size_t)ci * 128 + d] = __expf(bl);
  } else {
    unsigned pk[32];
    float kprev = 0.f;
#pragma unroll
    for (int t = 0; t < 64; t++) {
      float lf2 = LFs[t * 128 + d];
      float k = 1.f - __expf(lf2);
      Kt[t * 136 + d] = f2bf(k * __expf(rref - bc[t]));
      float kh = k * __expf(bl - bc[t]);
      if (t & 1) pk[t >> 1] = pack2(kprev, kh); else kprev = kh;
    }
#pragma unroll
    for (int q = 0; q < 8; q++) *(uint4*)&KT[d * 64 + q * 8] = make_uint4(pk[4 * q], pk[4 * q + 1], pk[4 * q + 2], pk[4 * q + 3]);
  }
  {
    unsigned pk[16];
#pragma unroll
    for (int s2 = 0; s2 < 16; s2++) {
      u16 a = VAs[(half * 32 + 2 * s2) * 128 + d];
      u16 b2 = VAs[(half * 32 + 2 * s2 + 1) * 128 + d];
      pk[s2] = (unsigned)a | ((unsigned)b2 << 16);
    }
#pragma unroll
    for (int q = 0; q < 4; q++) {
      uint4 v4 = make_uint4(pk[4 * q], pk[4 * q + 1], pk[4 * q + 2], pk[4 * q + 3]);
      *(uint4*)&VTs[d * 72 + half * 32 + q * 8] = v4;
      *(uint4*)&VT[d * 64 + half * 32 + q * 8] = v4;
    }
  }
  __syncthreads();
#pragma unroll
  for (int q = 0; q < 4; q++) {
    const int idx = tid + 256 * q, row = idx >> 4, c8 = idx & 15;
    *(uint4*)&QB[row * 128 + c8 * 8] = *(const uint4*)&QAs[row * 128 + c8 * 8];
  }
  {
    const int mi = w >> 1, ni = w & 1, r = lane & 31, hh = (lane >> 5) * 8;
    f32x16 at = zero16();
#pragma unroll
    for (int ks = 0; ks < 8; ks++) {
      bf16x8 a = *(const bf16x8*)&Qt[(mi * 32 + r) * 136 + ks * 16 + hh];
      bf16x8 bb = *(const bf16x8*)&Kt[(ni * 32 + r) * 136 + ks * 16 + hh];
      at = mfma16(a, bb, at);
    }
    const int s = ni * 32 + r;
#pragma unroll
    for (int e = 0; e < 16; e++) { const int t = mi * 32 + rowmap(e, lane); ATT[t * 72 + s] = f2bf(s <= t ? at[e] : 0.f); }
  }
  __syncthreads();
  {
    const int r = lane & 31, hh = (lane >> 5) * 8;
    const int mi = w & 1, ni0 = (w >> 1) * 2;
#pragma unroll
    for (int jj = 0; jj < 2; jj++) {
      const int ni = ni0 + jj;
      f32x16 o0 = zero16();
#pragma unroll
      for (int ks = 0; ks < 4; ks++) {
        bf16x8 a = *(const bf16x8*)&ATT[(mi * 32 + r) * 72 + ks * 16 + hh];
        bf16x8 bv = *(const bf16x8*)&VTs[(ni * 32 + r) * 72 + ks * 16 + hh];
        o0 = mfma16(a, bv, o0);
      }
#pragma unroll
      for (int e = 0; e < 16; e++) OT[(mi * 32 + rowmap(e, lane)) * 136 + ni * 32 + r] = f2bf(o0[e]);
    }
    __syncthreads();
#pragma unroll
    for (int q = 0; q < 4; q++) {
      const int idx = tid + 256 * q, row = idx >> 4, c8 = idx & 15;
      *(uint4*)&Oo[(size_t)(tok0 + row) * 512 + h * 128 + c8 * 8] = *(const uint4*)&OT[row * 136 + c8 * 8];
    }
  }
}

__device__ __forceinline__ void hgrn_sample_item(const Params& p, int item, char* smem) {
  const int tid = threadIdx.x, lane = tid & 63, w = tid >> 6;
  const int bs = item >> 2, h = item & 3;
  char* ws = p.ws;
  float* fq = (float*)smem;
  float* ff = fq + 512; float* fk = ff + 512; float* fv = fk + 512; float* part = fv + 512;
  float* red = part + 256;
  const float* LOGF = (const float*)(ws + OFF_LOGF);
  const u16* QA = (const u16*)((const char*)p.out + OUTB_QA);
  const u16* VA = (const u16*)(ws + OFF_VA);
  const int tokb = NTP + bs * 4;
  __syncthreads();
  if (tid < 128) {
#pragma unroll
    for (int t = 0; t < 4; t++) {
      size_t idx = (size_t)(tokb + t) * 512 + h * 128 + tid;
      float lf = LOGF[idx];
      ff[t * 128 + tid] = __expf(lf); fk[t * 128 + tid] = -expm1f(lf);
      fq[t * 128 + tid] = bf2f(QA[idx]); fv[t * 128 + tid] = bf2f(VA[idx]);
    }
  }
  __syncthreads();
  const int v = tid & 127, dh = tid >> 7;
  const float* s0 = p.state_hgrn + ((size_t)(bs * 4 + h) * 128 + dh * 64) * 128 + v;
  float S[64];
#pragma unroll
  for (int i = 0; i < 64; i++) S[i] = s0[(size_t)i * 128];
  float o4[4];
#pragma unroll
  for (int t = 0; t < 4; t++) {
    float os = 0.f; const float vv = fv[t * 128 + v];
#pragma unroll
    for (int i = 0; i < 64; i++) {
      const int dd = dh * 64 + i;
      S[i] = ff[t * 128 + dd] * S[i] + fk[t * 128 + dd] * vv;
      os += S[i] * fq[t * 128 + dd];
    }
    part[dh * 128 + v] = os;
    __syncthreads();
    o4[t] = part[v] + part[128 + v];
    __syncthreads();
  }
  float* so = p.out + OUT_HS + ((size_t)(bs * 4 + h) * 128 + dh * 64) * 128 + v;
#pragma unroll
  for (int i = 0; i < 64; i++) so[(size_t)i * 128] = S[i];
  u16* Oo = (u16*)(ws + OFF_O);
  float* SSQO = (float*)(ws + OFF_SSQO);
  if (dh == 0) {
#pragma unroll
    for (int t = 0; t < 4; t++) {
      Oo[(size_t)(tokb + t) * 512 + h * 128 + v] = f2bf(o4[t]);
      float s = wsum(o4[t] * o4[t]);
      if (lane == 0) red[t * 2 + w] = s;
    }
  }
  __syncthreads();
  if (tid < 4) {
    float* q = SSQO + ((size_t)(tokb + tid) * 4 + h) * 4;
    q[0] = red[tid * 2] + red[tid * 2 + 1]; q[1] = 0.f; q[2] = 0.f; q[3] = 0.f;
  }
}

__device__ __forceinline__ void gdn_sample_item(const Params& p, int item, char* smem) {
  const int tid = threadIdx.x, lane = tid & 63, w = tid >> 6;
  const int bs = item >> 2, h = item & 3;
  char* ws = p.ws;
  float* cq = (float*)smem;
  float* ck = cq + 512; float* cv = ck + 512; float* part = cv + 512;
  float* red = part + 256;
  float* sg = red + 16;
  const u16* RAW = (const u16*)((const char*)p.out + OUTB_RAW);
  const int tokb = NTP + bs * 4;
  __syncthreads();
  float cval[4];
  {
    const int type = tid >> 7, c = tid & 127;
    const int col = type * 512 + h * 128 + c;
    const float w0 = p.conv_w[col], w1 = p.conv_w[1536 + col], w2 = p.conv_w[3072 + col], w3 = p.conv_w[4608 + col];
    const float* sc = p.state_conv + (size_t)bs * 3 * 1536 + col;
    float x0 = sc[0], x1 = sc[1536], x2 = sc[3072];
#pragma unroll
    for (int t = 0; t < 4; t++) {
      float x3 = bf2f(RAW[(size_t)(tokb + t) * 1536 + col]);
      float c4 = x0 * w0 + x1 * w1 + x2 * w2 + x3 * w3;
      cval[t] = siluf_(c4);
      x0 = x1; x1 = x2; x2 = x3;
      float s = wsum(cval[t] * cval[t]);
      if (lane == 0) red[t * 4 + w] = s;
    }
  }
  if (tid < 128) {
    const int col = 1024 + h * 128 + tid;
    const float w0 = p.conv_w[col], w1 = p.conv_w[1536 + col], w2 = p.conv_w[3072 + col], w3 = p.conv_w[4608 + col];
    const float* sc = p.state_conv + (size_t)bs * 3 * 1536 + col;
    float x0 = sc[0], x1 = sc[1536], x2 = sc[3072];
#pragma unroll
    for (int t = 0; t < 4; t++) {
      float x3 = bf2f(RAW[(size_t)(tokb + t) * 1536 + col]);
      float c4 = x0 * w0 + x1 * w1 + x2 * w2 + x3 * w3;
      cv[t * 128 + tid] = siluf_(c4);
      x0 = x1; x1 = x2; x2 = x3;
    }
  }
  if (tid < 4) {
    sg[tid] = __expf(((const float*)(ws + OFF_GLOG))[(size_t)(tokb + tid) * 4 + h]);
    sg[4 + tid] = ((const float*)(ws + OFF_BETA))[(size_t)(tokb + tid) * 4 + h];
  }
  __syncthreads();
  {
    const int type = tid >> 7, c = tid & 127;
    float* dst = type ? ck : cq;
#pragma unroll
    for (int t = 0; t < 4; t++) {
      float rn = rsqrtf(red[t * 4 + type * 2] + red[t * 4 + type * 2 + 1] + EPSF);
      if (type == 0) rn *= 0.08838834764831845f;
      dst[t * 128 + c] = cval[t] * rn;
    }
  }
  __syncthreads();
  const int v = tid & 127, dh = tid >> 7;
  const float* s0 = p.state_delta + ((size_t)(bs * 4 + h) * 128 + dh * 64) * 128 + v;
  float S[64];
#pragma unroll
  for (int i = 0; i < 64; i++) S[i] = s0[(size_t)i * 128];
  float o4[4];
#pragma unroll
  for (int t = 0; t < 4; t++) {
    const float a = sg[t], bt = sg[4 + t];
    float ks = 0.f;
#pragma unroll
    for (int i = 0; i < 64; i++) ks += ck[t * 128 + dh * 64 + i] * S[i];
    part[dh * 128 + v] = ks;
    __syncthreads();
    const float kS = part[v] + part[128 + v];
    __syncthreads();
    const float u = bt * (cv[t * 128 + v] - a * kS);
    float os = 0.f;
#pragma unroll
    for (int i = 0; i < 64; i++) {
      const int dd = dh * 64 + i;
      S[i] = a * S[i] + ck[t * 128 + dd] * u;
      os += S[i] * cq[t * 128 + dd];
    }
    part[dh * 128 + v] = os;
    __syncthreads();
    o4[t] = part[v] + part[128 + v];
    __syncthreads();
  }
  float* so = p.out + OUT_DS + ((size_t)(bs * 4 + h) * 128 + dh * 64) * 128 + v;
#pragma unroll
  for (int i = 0; i < 64; i++) so[(size_t)i * 128] = S[i];
  u16* Oo = (u16*)(ws + OFF_O) + (size_t)NT * 512;
  float* SSQO = (float*)(ws + OFF_SSQO) + (size_t)NT * 16;
  if (dh == 0) {
#pragma unroll
    for (int t = 0; t < 4; t++) {
      Oo[(size_t)(tokb + t) * 512 + h * 128 + v] = f2bf(o4[t]);
      float s = wsum(o4[t] * o4[t]);
      if (lane == 0) red[t * 4 + w] = s;
    }
  }
  __syncthreads();
  if (tid < 4) {
    float* q = SSQO + ((size_t)(tokb + tid) * 4 + h) * 4;
    q[0] = red[tid * 4] + red[tid * 4 + 1]; q[1] = 0.f; q[2] = 0.f; q[3] = 0.f;
  }
}

__device__ __forceinline__ void phase2(const Params& p, char* smem, int lo = 0, int hi = 3072) {
  const int g = gridDim.x, bx = blockIdx.x;
#pragma unroll 1
  for (int it = lo + bx; it < hi && it < 1024; it += g) gdn_chunk_item(p, it, smem);
#pragma unroll 1
  for (int it = lo + bx + ((lo < 1024) ? ((1024 - lo - bx + g - 1) / g) * g : 0); it < hi && it < 2048; it += g) if (it >= 1024) hgrn_chunk_item(p, it - 1024, smem);
#pragma unroll 1
  for (int it = lo + bx + ((lo < 2048) ? ((2048 - lo - bx + g - 1) / g) * g : 0); it < hi && it < 2560; it += g) if (it >= 2048) gdn_sample_item(p, it - 2048, smem);
#pragma unroll 1
  for (int it = lo + bx + ((lo < 2560) ? ((2560 - lo - bx + g - 1) / g) * g : 0); it < hi; it += g) if (it >= 2560) hgrn_sample_item(p, it - 2560, smem);
}

__device__ __forceinline__ void seq_item(const Params& p, int item, char* smem, const bool write_o = true) {
  const int tid = threadIdx.x, lane = tid & 63, w = tid >> 6;
  const int m = 1 - (item >> 7); const int rem = item & 127; const int bh = rem >> 2, sl = rem & 3; const int b = bh >> 2, h = bh & 3;
  char* ws = p.ws;
  u16* STs = (u16*)smem;
  u16* VTs = (u16*)(smem + 8704);
  const int r = lane & 31, hh = (lane >> 5) * 8;
  const int dcol = w * 32 + r;
  u16* Om = (u16*)(ws + OFF_O) + (size_t)m * NT * 512;
  float* SSQO = (float*)(ws + OFF_SSQO) + (size_t)m * NT * 16;
  const float* DVEC = (const float*)(ws + OFF_DVEC);
  f32x16 S = zero16();
  __syncthreads();
  uint4 vt4; bf16x8 ktf[4], pnf[8], qbf[8]; float dvn; u16 o0[16];
#define SEQ_LOADS(n_)                                                                                           \
  {                                                                                                             \
    const int ci_ = m * 1024 + bh * 32 + (n_);                                                                  \
    const u16* QB_ = (const u16*)(ws + OFF_QB) + (size_t)ci_ * 8192;                                            \
    const u16* KT_ = (const u16*)(ws + OFF_KT) + (size_t)ci_ * 8192;                                            \
    const u16* VT_ = (const u16*)(ws + OFF_VT) + (size_t)ci_ * 8192;                                            \
    const u16* PN_ = (const u16*)(ws + OFF_PN) + (size_t)(bh * 32 + (n_)) * 16384;                              \
    vt4 = *(const uint4*)(VT_ + (sl * 32 + (tid >> 3)) * 64 + (tid & 7) * 8);                                   \
    dvn = DVEC[(size_t)ci_ * 128 + dcol];                                                                       \
    _Pragma("unroll") for (int ks = 0; ks < 4; ks++) ktf[ks] = *(const bf16x8*)(KT_ + dcol * 64 + ks * 16 + hh); \
    if (m == 1) { _Pragma("unroll") for (int ks = 0; ks < 8; ks++) pnf[ks] = *(const bf16x8*)(PN_ + dcol * 128 + ks * 16 + hh); } \
    if (w < 2) {                                                                                                \
      _Pragma("unroll") for (int ks = 0; ks < 8; ks++) qbf[ks] = *(const bf16x8*)(QB_ + (w * 32 + r) * 128 + ks * 16 + hh); \
      const int tok0_ = b * 2048 + (n_) * 64;                                                                   \
      _Pragma("unroll") for (int e = 0; e < 16; e++) o0[e] = Om[(size_t)(tok0_ + w * 32 + rowmap(e, lane)) * 512 + h * 128 + sl * 32 + r]; \
    }                                                                                                           \
  }
  SEQ_LOADS(0)
#pragma unroll 1
  for (int n = 0; n < 32; n++) {
#pragma unroll
    for (int e = 0; e < 16; e++) STs[rowmap(e, lane) * 136 + dcol] = f2bf(S[e]);
    *(uint4*)&VTs[(tid >> 3) * 72 + (tid & 7) * 8] = vt4;
    __syncthreads();
    const int tok0 = b * 2048 + n * 64;
    if (w < 2) {
      f32x16 o;
#pragma unroll
      for (int e = 0; e < 16; e++) o[e] = bf2f(o0[e]);
#pragma unroll
      for (int ks = 0; ks < 8; ks++) {
        bf16x8 bb = *(const bf16x8*)&STs[r * 136 + ks * 16 + hh];
        o = mfma16(qbf[ks], bb, o);
      }
#pragma unroll
      for (int e = 0; e < 16; e++) {
        const int t = w * 32 + rowmap(e, lane);
        if (write_o) Om[(size_t)(tok0 + t) * 512 + h * 128 + sl * 32 + r] = f2bf(o[e]);
        float sq = sum32(o[e] * o[e]);
        if (r == 0) SSQO[((size_t)(tok0 + t) * 4 + h) * 4 + sl] = sq;
      }
    }
#pragma unroll
    for (int e = 0; e < 16; e++) S[e] *= dvn;
#pragma unroll
    for (int ks = 0; ks < 4; ks++) {
      bf16x8 a = *(const bf16x8*)&VTs[r * 72 + ks * 16 + hh];
      S = mfma16(a, ktf[ks], S);
    }
    if (m == 1) {
#pragma unroll
      for (int ks = 0; ks < 8; ks++) {
        bf16x8 a = *(const bf16x8*)&STs[r * 136 + ks * 16 + hh];
        S = mfma16(a, pnf[ks], S);
      }
    }
    if (n + 1 < 32) SEQ_LOADS(n + 1)
    __syncthreads();
  }
  float* so = p.out + (m == 0 ? OUT_HP : OUT_DP) + (size_t)bh * 16384;
#pragma unroll
  for (int g = 0; g < 4; g++) {
    const int v0 = 8 * g + (lane >> 5) * 4;
    *(float4*)(so + (size_t)dcol * 128 + sl * 32 + v0) = make_float4(S[4 * g], S[4 * g + 1], S[4 * g + 2], S[4 * g + 3]);
  }
}
__device__ __forceinline__ void phase3(const Params& p, char* smem, const bool write_o = true) {
  for (int it = blockIdx.x; it < 256; it += gridDim.x) seq_item(p, it, smem, write_o);
}

__device__ __forceinline__ void phase4a(const Params& p, char* smem) {
  const int tid = threadIdx.x, lane = tid & 63, w = tid >> 6, wm = w >> 1, wn = w & 1;
  char* ws = p.ws;
  const u16* H = (const u16*)(ws + OFF_H);
  const u16* WTIN = (const u16*)(ws + OFF_WT_IN);
  u16* MRG = (u16*)(ws + OFF_MRG);
  const int NG = 132 * 8;
  const int NCONV = 4096;
  float* gnL = (float*)(smem + 141312);
  if (tid < 128) { gnL[tid] = p.g_norm_a[tid]; gnL[128 + tid] = p.g_norm_b[tid]; }
  __syncthreads();
  const int G = (int)gridDim.x;
  const int nfull = NG / G;
  const int nleft = NG - nfull * G;
  const bool split_ok = (2 * nleft <= G) && (nleft <= P4A_MAX_LEFT);
  const int bx = (int)blockIdx.x;
  int nunits = 2 * nfull;
  if (split_ok) { if (bx < 2 * nleft) nunits += 1; } else { if (bx < nleft) nunits += 2; }
  u16* MRG2 = (u16*)(ws + OFF_MRG2);
#pragma unroll 1
  for (int un = 0; un < nunits; un++) {
    int it, mix; bool side = false;
    if (un < 2 * nfull) { it = bx + (un >> 1) * G; mix = un & 1; }
    else if (split_ok) { it = nfull * G + (bx >> 1); mix = bx & 1; side = (mix == 1); }
    else { it = nfull * G + bx; mix = un & 1; }
    const bool add = (mix == 1) && !side;
    const int nt = it & 7, mt = it >> 3;
    const int m0 = mt * 128, n0 = nt * 128;
    unsigned sg[2][2][8];
    f32x16 acc[2][2];
    {
      zero_acc(acc);
      LoadBf16 lh{H + (size_t)m0 * 1024, 1024};
      gemm_mainloop(acc, lh, WTIN + (size_t)(4096 + mix * 1024 + n0) * 1024, 1024, 1024, smem);
#pragma unroll
      for (int i = 0; i < 2; i++)
#pragma unroll
        for (int j = 0; j < 2; j++)
#pragma unroll
          for (int e = 0; e < 8; e++) sg[i][j][e] = pack2(sigmoidf_(acc[i][j][2 * e]), sigmoidf_(acc[i][j][2 * e + 1]));
      zero_acc(acc);
      float* rstdL = (float*)(smem + 139264);
      {
        const float* sq = (const float*)(ws + OFF_SSQO) + ((size_t)mix * NT + m0) * 16;
        const float4 s0 = *(const float4*)(sq + tid * 8), s1 = *(const float4*)(sq + tid * 8 + 4);
        rstdL[tid * 2] = rsqrtf((s0.x + s0.y + s0.z + s0.w) * (1.f / 128.f) + EPSF);
        rstdL[tid * 2 + 1] = rsqrtf((s1.x + s1.y + s1.z + s1.w) * (1.f / 128.f) + EPSF);
      }
      LoadNormO lo{(const u16*)(ws + OFF_O) + ((size_t)mix * NT + m0) * 512,
                   (const u16*)(ws + (mix ? OFF_ZB : OFF_OGA)) + (size_t)m0 * 512,
                   rstdL, gnL + mix * 128};
      gemm_mainloop(acc, lo, (const u16*)(ws + (mix ? OFF_WT_BRB : OFF_WT_BRA)) + (size_t)n0 * 512, 512, 512, smem);
      {
        u16* T = (u16*)smem;
#pragma unroll
        for (int i = 0; i < 2; i++)
#pragma unroll
          for (int j = 0; j < 2; j++)
#pragma unroll
            for (int e = 0; e < 16; e++) {
              const float g0 = (e & 1) ? bfhi(sg[i][j][e >> 1]) : bflo(sg[i][j][e >> 1]);
              T[(wm * 64 + i * 32 + rowmap(e, lane)) * 136 + wn * 64 + j * 32 + (lane & 31)] = f2bf(g0 * acc[i][j][e]);
            }
        __syncthreads();
        u16* dbase = side ? MRG2 + (size_t)(it - nfull * G) * 16384 : MRG + (size_t)m0 * 1024 + n0;
        const int dld = side ? 128 : 1024;
#pragma unroll
        for (int q = 0; q < 8; q++) {
          const int idx = tid + 256 * q, row = idx >> 4, c8 = idx & 15;
          uint4 v4 = *(const uint4*)&T[row * 136 + c8 * 8];
          u16* mp = dbase + (size_t)row * dld + c8 * 8;
          if (add) {
            const uint4 o4 = *(const uint4*)mp;
            v4.x = pack2(bflo(v4.x) + bflo(o4.x), bfhi(v4.x) + bfhi(o4.x));
            v4.y = pack2(bflo(v4.y) + bflo(o4.y), bfhi(v4.y) + bfhi(o4.y));
            v4.z = pack2(bflo(v4.z) + bflo(o4.z), bfhi(v4.z) + bfhi(o4.z));
            v4.w = pack2(bflo(v4.w) + bflo(o4.w), bfhi(v4.w) + bfhi(o4.w));
          }
          *(uint4*)mp = v4;
        }
      }
    }
  }
  {
    const int extra = split_ok ? 2 * nleft : nleft;
    int first = bx - extra, stride = G - extra;
    if (stride <= 0) { first = bx; stride = G; }
    if (first >= 0) {
#pragma unroll 1
      for (int ci = first; ci < NCONV; ci += stride) {
        if (ci < 2048) convert_item_fp8(p.expert_u, (unsigned char*)(ws + OFF_EU), ci, EU_SCALE);
        else convert_item_fp8(p.expert_v, (unsigned char*)(ws + OFF_EV), ci - 2048, EV_SCALE);
      }
    }
  }
}

__device__ __forceinline__ void phase4a_fixup(const Params& p) {
  const int tid = threadIdx.x;
  char* ws = p.ws;
  const int NG = 132 * 8, G = (int)gridDim.x;
  const int nfull = NG / G, nleft = NG - nfull * G;
  const bool split_ok = (2 * nleft <= G) && (nleft <= P4A_MAX_LEFT);
  if (!split_ok || (int)blockIdx.x >= nleft) return;
  const int it = nfull * G + (int)blockIdx.x;
  const int nt = it & 7, mt = it >> 3;
  u16* MRG = (u16*)(ws + OFF_MRG) + (size_t)mt * 128 * 1024 + nt * 128;
  const u16* MRG2 = (const u16*)(ws + OFF_MRG2) + (size_t)blockIdx.x * 16384;
#pragma unroll
  for (int q = 0; q < 8; q++) {
    const int idx = tid + 256 * q, row = idx >> 4, c8 = idx & 15;
    u16* mp = MRG + (size_t)row * 1024 + c8 * 8;
    uint4 v4 = *(const uint4*)mp;
    const uint4 o4 = *(const uint4*)(MRG2 + row * 128 + c8 * 8);
    v4.x = pack2(bflo(v4.x) + bflo(o4.x), bfhi(v4.x) + bfhi(o4.x));
    v4.y = pack2(bflo(v4.y) + bflo(o4.y), bfhi(v4.y) + bfhi(o4.y));
    v4.z = pack2(bflo(v4.z) + bflo(o4.z), bfhi(v4.z) + bfhi(o4.z));
    v4.w = pack2(bflo(v4.w) + bflo(o4.w), bfhi(v4.w) + bfhi(o4.w));
    *(uint4*)mp = v4;
  }
}

__device__ __forceinline__ void phase4b(const Params& p, char* smem) {
  const int tid = threadIdx.x, lane = tid & 63, w = tid >> 6, wm = w >> 1, wn = w & 1;
  char* ws = p.ws;
  const u16* MRG = (const u16*)(ws + OFF_MRG);
  float* X1 = p.out + OUT_Y;
  float* SSQ1 = (float*)(ws + OFF_SSQ1);
  for (int it = blockIdx.x; it < 132 * 8; it += gridDim.x) {
    const int nt = it & 7, mt = it >> 3;
    const int m0 = mt * 128, n0 = nt * 128;
    f32x16 acc[2][2]; zero_acc(acc);
    LoadBf16 al{MRG + (size_t)m0 * 1024, 1024};
    gemm_mainloop(acc, al, (const u16*)(ws + OFF_WT_OUT) + (size_t)n0 * 1024, 1024, 1024, smem);
#pragma unroll
    for (int i = 0; i < 2; i++)
#pragma unroll
      for (int e = 0; e < 16; e++) {
        const int row = m0 + wm * 64 + i * 32 + rowmap(e, lane);
        const float* xr = xrow(p, row);
        float sq = 0.f;
#pragma unroll
        for (int j = 0; j < 2; j++) {
          const int col = n0 + wn * 64 + j * 32 + (lane & 31);
          float v = acc[i][j][e] + xr[col];
          X1[(size_t)row * 1024 + col] = v;
          ((u16*)smem)[(row - m0) * 136 + (col - n0)] = f2bf(v);
          sq += v * v;
        }
        sq = sum32(sq);
        if ((lane & 31) == 0) atomicAdd(&SSQ1[row], sq);
      }
    {
      const u16* T = (const u16*)smem;
      u16* X1B = (u16*)(ws + OFF_X1B);
      __syncthreads();
#pragma unroll
      for (int q = 0; q < 8; q++) {
        const int idx = tid + 256 * q, row = idx >> 4, c8 = idx & 15;
        *(uint4*)(X1B + (size_t)(m0 + row) * 1024 + n0 + c8 * 8) = *(const uint4*)&T[row * 136 + c8 * 8];
      }
    }
  }
}

__device__ __forceinline__ void phase4c(const Params& p, char* smem) {
  const int tid = threadIdx.x, lane = tid & 63, w = tid >> 6, wm = w >> 1, wn = w & 1;
  char* ws = p.ws;
  const float* X1 = p.out + OUT_Y;
  const float* SSQ1 = (const float*)(ws + OFF_SSQ1);
  u16* H2 = (u16*)(ws + OFF_H2);
  float* TOPS = (float*)(ws + OFF_TOPS); int* TOPI = (int*)(ws + OFF_TOPI);
  const u16* KEYS = (const u16*)(ws + OFF_KEYS);
  for (int it = blockIdx.x; it < 132 * 16; it += gridDim.x) {
    const int nt = it & 15, mt = it >> 4;
    const int m0 = mt * 128, n0 = nt * 128;
    f32x16 acc[2][2]; zero_acc(acc);
    gemm_mainloop_dma(acc, (const u16*)(ws + OFF_X1B) + (size_t)m0 * 1024, 1024, (const u16*)(ws + OFF_WT_Q) + (size_t)n0 * 1024, 1024, 1024, smem);
    u16* Aq = (u16*)smem;
    u16* Bk = Aq + 128 * 136;
    const int r = lane & 31, hh = (lane >> 5) * 8;
#pragma unroll
    for (int i = 0; i < 2; i++)
#pragma unroll
      for (int j = 0; j < 2; j++)
#pragma unroll
        for (int e = 0; e < 16; e++) {
          const int rl = wm * 64 + i * 32 + rowmap(e, lane);
          const float rs = rsqrtf(SSQ1[m0 + rl] * (1.f / 1024.f) + EPSF);
          Aq[rl * 136 + wn * 64 + j * 32 + r] = f2bf(acc[i][j][e] * rs);
        }
#pragma unroll
    for (int q = 0; q < 8; q++) {
      int idx = tid + 256 * q; int row = idx >> 4, ch = idx & 15;
      *(uint4*)&Bk[row * 136 + ch * 8] = *(const uint4*)(KEYS + ((size_t)nt * 128 + row) * 128 + ch * 8);
    }
    __syncthreads();
    zero_acc(acc);
#pragma unroll
    for (int ks = 0; ks < 8; ks++) {
      bf16x8 a[2], bq[2];
#pragma unroll
      for (int i = 0; i < 2; i++) a[i] = *(const bf16x8*)&Aq[(wm * 64 + i * 32 + r) * 136 + ks * 16 + hh];
#pragma unroll
      for (int j = 0; j < 2; j++) bq[j] = *(const bf16x8*)&Bk[(wn * 64 + j * 32 + r) * 136 + ks * 16 + hh];
#pragma unroll
      for (int i = 0; i < 2; i++)
#pragma unroll
        for (int j = 0; j < 2; j++) acc[i][j] = mfma16(a[i], bq[j], acc[i][j]);
    }
    __syncthreads();
    float* SC = (float*)smem;
#pragma unroll
    for (int i = 0; i < 2; i++)
#pragma unroll
      for (int j = 0; j < 2; j++)
#pragma unroll
        for (int e = 0; e < 16; e++) SC[(wm * 64 + i * 32 + rowmap(e, lane)) * 132 + wn * 64 + j * 32 + r] = acc[i][j][e];
    __syncthreads();
    {
      const int tokl = tid >> 1, part = tid & 1;
      float sv[64];
#pragma unroll
      for (int i = 0; i < 16; i++) {
        float4 x = *(const float4*)&SC[tokl * 132 + part * 64 + i * 4];
        const unsigned ib = 127u - (unsigned)(part * 64 + i * 4);
        sv[4 * i]     = __uint_as_float((__float_as_uint(x.x) & ~127u) | ib);
        sv[4 * i + 1] = __uint_as_float((__float_as_uint(x.y) & ~127u) | (ib - 1u));
        sv[4 * i + 2] = __uint_as_float((__float_as_uint(x.z) & ~127u) | (ib - 2u));
        sv[4 * i + 3] = __uint_as_float((__float_as_uint(x.w) & ~127u) | (ib - 3u));
      }
#define CE_DESC(a, b) { const float hi_ = fmaxf(a, b), lo_ = fminf(a, b); a = hi_; b = lo_; }
#pragma unroll
      for (int g = 0; g < 4; g++) {
#pragma unroll
        for (int lk = 1; lk <= 4; lk++) {
#pragma unroll
          for (int lj = lk - 1; lj >= 0; lj--) {
#pragma unroll
            for (int i = 0; i < 16; i++) {
              const int l = i ^ (1 << lj);
              if (l > i) {
                if ((i & (1 << lk)) == 0) { CE_DESC(sv[g * 16 + i], sv[g * 16 + l]) } else { CE_DESC(sv[g * 16 + l], sv[g * 16 + i]) }
              }
            }
          }
        }
      }
#define MERGE16(A0, B0)                                                                             \
      {                                                                                             \
        _Pragma("unroll") for (int i = 0; i < 16; i++) sv[(A0) + i] = fmaxf(sv[(A0) + i], sv[(B0) + 15 - i]); \
        _Pragma("unroll") for (int lj = 3; lj >= 0; lj--) {                                         \
          _Pragma("unroll") for (int i = 0; i < 16; i++) {                                          \
            const int l = i ^ (1 << lj);                                                            \
            if (l > i) { CE_DESC(sv[(A0) + i], sv[(A0) + l]) }                                      \
          }                                                                                         \
        }                                                                                           \
      }
      MERGE16(0, 16)
      MERGE16(32, 48)
      MERGE16(0, 32)
#pragma unroll
      for (int i = 0; i < 16; i++) sv[16 + i] = DPP_F(sv[i], 0xB1);
      MERGE16(0, 16)
      if (part == 0) {
        const size_t ob = ((size_t)(m0 + tokl) * 16 + nt) * 16;
#pragma unroll
        for (int q = 0; q < 4; q++) {
          *(float4*)(TOPS + ob + q * 4) = make_float4(sv[4 * q], sv[4 * q + 1], sv[4 * q + 2], sv[4 * q + 3]);
          *(int4*)(TOPI + ob + q * 4) = make_int4(127 - (int)(__float_as_uint(sv[4 * q]) & 127u), 127 - (int)(__float_as_uint(sv[4 * q + 1]) & 127u),
                                                  127 - (int)(__float_as_uint(sv[4 * q + 2]) & 127u), 127 - (int)(__float_as_uint(sv[4 * q + 3]) & 127u));
        }
      }
    }
  }
}

__device__ __forceinline__ float gelu_tanh(float x) {
  float u = 0.7978845608028654f * (x + 0.044715f * x * x * x);
  return 0.5f * x * (1.f + tanhf(u));
}
__device__ const unsigned char cand_tab[56] = {
  0x00,0x01,0x02,0x03,0x04,0x05,0x06,0x07,0x08,0x09,0x0a,0x0b,0x0c,0x0d,0x0e,0x0f,
  0x10,0x11,0x12,0x13,0x14,0x15,0x16,0x17,
  0x20,0x21,0x22,0x23,0x24,
  0x30,0x31,0x32,0x33,
  0x40,0x41,0x42,
  0x50,0x51, 0x60,0x61, 0x70,0x71,
  0x80,0x90,0xa0,0xb0,0xc0,0xd0,0xe0,0xf0,
  0,0,0,0,0,0};

#define P5_LOAD(A, TAB, j0)                                                                \
  _Pragma("unroll") for (int q = 0; q < 16; q++) {                                         \
    A[q] = ((const uint4*)((TAB) + (size_t)widx[(j0) + q] * 1024))[lane];                  \
  }
#define P5_FMA2(acc_, d_, i_)                                                              \
  acc_ = __builtin_elementwise_fma(__builtin_amdgcn_cvt_pk_f32_fp8((int)(d_), false), h2[2 * (i_)], acc_); \
  acc_ = __builtin_elementwise_fma(__builtin_amdgcn_cvt_pk_f32_fp8((int)(d_), true), h2[2 * (i_) + 1], acc_);
#define P5_COMPUTE_U(A, j0)                                                                                 \
  {                                                                                                         \
    float d_[16];                                                                                           \
    _Pragma("unroll") for (int q = 0; q < 16; q++) {                                                        \
      float2v ac_ = {0.f, 0.f};                                                                             \
      P5_FMA2(ac_, A[q].x, 0) P5_FMA2(ac_, A[q].y, 1) P5_FMA2(ac_, A[q].z, 2) P5_FMA2(ac_, A[q].w, 3)       \
      d_[q] = ac_.x + ac_.y;                                                                                \
    }                                                                                                       \
    _Pragma("unroll") for (int i = 0; i < 8; i++) { bool hi_ = lane & 32; float sd = hi_ ? d_[i] : d_[i + 8]; float kp = hi_ ? d_[i + 8] : d_[i]; d_[i] = kp + __shfl_xor(sd, 32); } \
    _Pragma("unroll") for (int i = 0; i < 4; i++) { bool hi_ = lane & 16; float sd = hi_ ? d_[i] : d_[i + 4]; float kp = hi_ ? d_[i + 4] : d_[i]; d_[i] = kp + __shfl_xor(sd, 16); } \
    _Pragma("unroll") for (int i = 0; i < 2; i++) { bool hi_ = lane & 8; float sd = hi_ ? d_[i] : d_[i + 2]; float kp = hi_ ? d_[i + 2] : d_[i]; d_[i] = kp + __shfl_xor(sd, 8); }   \
    { bool hi_ = lane & 4; float sd = hi_ ? d_[0] : d_[1]; float kp = hi_ ? d_[1] : d_[0]; d_[0] = kp + __shfl_xor(sd, 4); }   \
    float a_ = d_[0];                                                                                       \
    a_ += DPP_F(a_, 0x4E); a_ += DPP_F(a_, 0xB1);                                                           \
    if ((lane & 3) == 0) { const int j_ = (j0) + (lane >> 2); wwt[j_] = wgate[j_] * gelu_tanh(a_ * (1.f / EU_SCALE)) * (1.f / EV_SCALE); } \
  }
#define P5_ACC2(d_, i_, w2_)                                                               \
  o2[2 * (i_)] = __builtin_elementwise_fma(__builtin_amdgcn_cvt_pk_f32_fp8((int)(d_), false), w2_, o2[2 * (i_)]); \
  o2[2 * (i_) + 1] = __builtin_elementwise_fma(__builtin_amdgcn_cvt_pk_f32_fp8((int)(d_), true), w2_, o2[2 * (i_) + 1]);
#define P5_COMPUTE_V(A, j0)                                                                                 \
  _Pragma("unroll") for (int q = 0; q < 16; q++) {                                                          \
    const float wt = wwt[(j0) + q];                                                                         \
    const float2v w2_ = {wt, wt};                                                                           \
    P5_ACC2(A[q].x, 0, w2_) P5_ACC2(A[q].y, 1, w2_) P5_ACC2(A[q].z, 2, w2_) P5_ACC2(A[q].w, 3, w2_)         \
  }

__device__ __forceinline__ void phase5(const Params& p, char* smem, const bool store_x = true) {
  const int tid = threadIdx.x, lane = tid & 63, w = tid >> 6;
  char* ws = p.ws;
  int* widx = (int*)(smem + w * 4096);
  float* wgate = (float*)(smem + w * 4096 + 512);
  float* wwt = (float*)(smem + w * 4096 + 1024);
  int* wcnt = (int*)(smem + w * 4096 + 1536);
  float* tsL = (float*)(smem + w * 4096 + 2048);
  int* tiL = (int*)(smem + w * 4096 + 3072);
  unsigned char* ctab = (unsigned char*)(smem + 16384);
  const float* TOPS = (const float*)(ws + OFF_TOPS); const int* TOPI = (const int*)(ws + OFF_TOPI);
  const u16* H2 = (const u16*)(ws + OFF_H2);
  const unsigned char* EU = (const unsigned char*)(ws + OFF_EU); const unsigned char* EV = (const unsigned char*)(ws + OFF_EV);
  float* X = p.out + OUT_Y;
  u16* H3 = (u16*)(ws + OFF_H3);
  __syncthreads();
  if (tid < 56) ctab[tid] = cand_tab[tid];
  __syncthreads();
  uint4 pf_ts, pf_ti, pf_ha, pf_hb; float pf_ss = 1.f;
  const u16* X1B = (const u16*)(ws + OFF_X1B);
  const float* SSQ1 = (const float*)(ws + OFF_SSQ1);
  float2v gf[8];
#pragma unroll
  for (int i = 0; i < 4; i++) { const float4 g4 = *(const float4*)(p.g_ffn + lane * 16 + i * 4); gf[2 * i] = float2v{g4.x, g4.y}; gf[2 * i + 1] = float2v{g4.z, g4.w}; }
  {
    const int tok0 = (int)blockIdx.x * 4 + w;
    if (tok0 < NT) {
      pf_ts = ((const uint4*)(TOPS + (size_t)tok0 * 256))[lane];
      pf_ti = ((const uint4*)(TOPI + (size_t)tok0 * 256))[lane];
      pf_ha = *(const uint4*)(X1B + (size_t)tok0 * 1024 + lane * 16);
      pf_hb = *(const uint4*)(X1B + (size_t)tok0 * 1024 + lane * 16 + 8);
      pf_ss = SSQ1[tok0];
    }
  }
  for (int it = blockIdx.x; it < NT / 4; it += gridDim.x) {
    const int tok = it * 4 + w;
    float* xr = X + (size_t)tok * 1024 + lane * 16;
    const float4 xv0 = *(const float4*)(xr), xv1 = *(const float4*)(xr + 4), xv2 = *(const float4*)(xr + 8), xv3 = *(const float4*)(xr + 12);
    ((uint4*)tsL)[lane] = pf_ts;
    ((uint4*)tiL)[lane] = pf_ti;
    const uint4 cur_ha = pf_ha, cur_hb = pf_hb; const float cur_rs = rsqrtf(pf_ss * (1.f / 1024.f) + EPSF);
    {
      const int itn = it + (int)gridDim.x;
      if (itn < NT / 4) {
        const int tokn = itn * 4 + w;
        pf_ts = ((const uint4*)(TOPS + (size_t)tokn * 256))[lane];
        pf_ti = ((const uint4*)(TOPI + (size_t)tokn * 256))[lane];
        pf_ha = *(const uint4*)(X1B + (size_t)tokn * 1024 + lane * 16);
        pf_hb = *(const uint4*)(X1B + (size_t)tokn * 1024 + lane * 16 + 8);
        pf_ss = SSQ1[tokn];
      }
    }
    {
      const int hd = lane >> 3, g = lane & 7;
      const float* ts = tsL + hd * 32;
      const int* ti = tiL + hd * 32;
      float key[7]; int ij[7];
#pragma unroll
      for (int sl = 0; sl < 7; sl++) {
        const int cid = g * 7 + sl;
        const int t = ctab[cid];
        ij[sl] = t;
        float sum = ts[t >> 4] + ts[16 + (t & 15)];
        unsigned k = (__float_as_uint(sum) & ~63u) | (unsigned)cid;
        key[sl] = cid < 50 ? __uint_as_float(k) : NINF;
      }
      if (lane < 8) wcnt[lane] = 0;
      float m = 3.0e38f, m1 = 0.f;
#pragma unroll 1
      for (int rd = 0; rd < 16; rd++) {
        float loc = NINF;
#pragma unroll
        for (int sl = 0; sl < 7; sl++) loc = fmaxf(loc, key[sl] < m ? key[sl] : NINF);
        loc = fmaxf(loc, DPP_F(loc, 0xB1)); loc = fmaxf(loc, DPP_F(loc, 0x4E)); loc = fmaxf(loc, DPP_F(loc, 0x141));
        if (rd == 0) m1 = loc;
        m = loc;
      }
      float ev[7]; float es = 0.f;
#pragma unroll
      for (int sl = 0; sl < 7; sl++) { ev[sl] = key[sl] >= m ? __expf(key[sl] - m1) : 0.f; es += ev[sl]; }
      es += DPP_F(es, 0xB1); es += DPP_F(es, 0x4E); es += DPP_F(es, 0x141);
      const float inv = 1.f / es;
#pragma unroll
      for (int sl = 0; sl < 7; sl++) {
        if (key[sl] >= m) {
          int pos = atomicAdd(&wcnt[hd], 1);
          int ia = ti[ij[sl] >> 4], ib = ti[16 + (ij[sl] & 15)];
          widx[hd * 16 + pos] = ia * 128 + ib;
          wgate[hd * 16 + pos] = ev[sl] * inv;
        }
      }
    }
    float2v h2[8];
    {
      const uint4 a = cur_ha;
      const uint4 b2 = cur_hb;
      h2[0] = float2v{bflo(a.x), bfhi(a.x)}; h2[1] = float2v{bflo(a.y), bfhi(a.y)}; h2[2] = float2v{bflo(a.z), bfhi(a.z)}; h2[3] = float2v{bflo(a.w), bfhi(a.w)};
      h2[4] = float2v{bflo(b2.x), bfhi(b2.x)}; h2[5] = float2v{bflo(b2.y), bfhi(b2.y)}; h2[6] = float2v{bflo(b2.z), bfhi(b2.z)}; h2[7] = float2v{bflo(b2.w), bfhi(b2.w)};
#pragma unroll
      for (int i = 0; i < 8; i++) h2[i] = h2[i] * gf[i] * cur_rs;
    }
    uint4 A0[16], A1[16];
    P5_LOAD(A0, EU, 0)
#pragma unroll 1
    for (int j0 = 0; j0 < 128; j0 += 32) {
      P5_LOAD(A1, EU, j0 + 16)
      P5_COMPUTE_U(A0, j0)
      if (j0 + 32 < 128) { P5_LOAD(A0, EU, j0 + 32) } else { P5_LOAD(A0, EV, 0) }
      P5_COMPUTE_U(A1, j0 + 16)
    }
    float2v o2[8];
#pragma unroll
    for (int i = 0; i < 8; i++) o2[i] = float2v{0.f, 0.f};
#pragma unroll 1
    for (int j0 = 0; j0 < 128; j0 += 32) {
      P5_LOAD(A1, EV, j0 + 16)
      P5_COMPUTE_V(A0, j0)
      if (j0 + 32 < 128) { P5_LOAD(A0, EV, j0 + 32) }
      P5_COMPUTE_V(A1, j0 + 16)
    }
    float x2[16];
#pragma unroll
    for (int i = 0; i < 4; i++) {
      const float4 xv = i == 0 ? xv0 : i == 1 ? xv1 : i == 2 ? xv2 : xv3;
      x2[4 * i] = xv.x + o2[2 * i].x; x2[4 * i + 1] = xv.y + o2[2 * i].y; x2[4 * i + 2] = xv.z + o2[2 * i + 1].x; x2[4 * i + 3] = xv.w + o2[2 * i + 1].y;
    }
    float ss = 0.f;
#pragma unroll
    for (int i = 0; i < 16; i++) ss += x2[i] * x2[i];
    ss = wsum(ss);
    const float rs = rsqrtf(ss * (1.f / 1024.f) + EPSF);
    if (store_x) {
#pragma unroll
      for (int i = 0; i < 4; i++) *(float4*)(xr + i * 4) = make_float4(x2[4 * i], x2[4 * i + 1], x2[4 * i + 2], x2[4 * i + 3]);
    }
    unsigned hp[8];
#pragma unroll
    for (int i = 0; i < 4; i++) {
      const float4 g = *(const float4*)(p.g_ple + lane * 16 + i * 4);
      hp[2 * i] = pack2(x2[4 * i] * rs * g.x, x2[4 * i + 1] * rs * g.y);
      hp[2 * i + 1] = pack2(x2[4 * i + 2] * rs * g.z, x2[4 * i + 3] * rs * g.w);
    }
    *(uint4*)(H3 + (size_t)tok * 1024 + lane * 16) = make_uint4(hp[0], hp[1], hp[2], hp[3]);
    *(uint4*)(H3 + (size_t)tok * 1024 + lane * 16 + 8) = make_uint4(hp[4], hp[5], hp[6], hp[7]);
  }
}

__device__ __forceinline__ void phase6(const Params& p, char* smem) {
  const int tid = threadIdx.x, lane = tid & 63, w = tid >> 6, wm = w >> 1, wn = w & 1;
  char* ws = p.ws;
  const u16* H3 = (const u16*)(ws + OFF_H3);
  float* X = p.out + OUT_Y;
  float* SSQ3 = (float*)(ws + OFF_SSQ3);
  for (int it = blockIdx.x; it < 132 * 8; it += gridDim.x) {
    const int nt = it & 7, mt = it >> 3;
    const int m0 = mt * 128, n0 = nt * 128;
    f32x16 acc1[2][2]; zero_acc(acc1);
    unsigned pe[2][2][8];
    {
      LoadF32 lp{m0 < NTP ? p.p_prompt + (size_t)m0 * 256 : p.p_sample + (size_t)(m0 - NTP) * 256, 256};
      gemm_mainloop(acc1, lp, (const u16*)(ws + OFF_WT_PLE) + (size_t)n0 * 256, 256, 256, smem);
#pragma unroll
      for (int i = 0; i < 2; i++)
#pragma unroll
        for (int j = 0; j < 2; j++)
#pragma unroll
          for (int e = 0; e < 8; e++) pe[i][j][e] = pack2(acc1[i][j][2 * e], acc1[i][j][2 * e + 1]);
      zero_acc(acc1);
    }
    LoadBf16 al{H3 + (size_t)m0 * 1024, 1024};
    gemm_mainloop(acc1, al, (const u16*)(ws + OFF_WT_PG) + (size_t)n0 * 1024, 1024, 1024, smem);
#pragma unroll
    for (int i = 0; i < 2; i++)
#pragma unroll
      for (int e = 0; e < 16; e++) {
        const int row = m0 + wm * 64 + i * 32 + rowmap(e, lane);
        float sq = 0.f;
#pragma unroll
        for (int j = 0; j < 2; j++) {
          const int col = n0 + wn * 64 + j * 32 + (lane & 31);
          float* xp = X + (size_t)row * 1024 + col;
          float v = *xp + ((e & 1) ? bfhi(pe[i][j][e >> 1]) : bflo(pe[i][j][e >> 1])) * sigmoidf_(acc1[i][j][e]);
          *xp = v;
          sq += v * v;
        }
        sq = sum32(sq);
        if ((lane & 31) == 0) atomicAdd(&SSQ3[row], sq);
      }
  }
}

__device__ __forceinline__ void phase7(const Params& p) {
  const int tid = threadIdx.x;
  float* X = p.out + OUT_Y;
  const float* SSQ3 = (const float*)(p.ws + OFF_SSQ3);
  for (int it = blockIdx.x; it < NT / 2; it += gridDim.x) {
    const size_t base = (size_t)it * 2048 + (size_t)tid * 8;
    const int row = (int)(base >> 10), k = (int)(base & 1023);
    const float rs = rsqrtf(SSQ3[row] * (1.f / 1024.f) + EPSF);
    float4 a = *(const float4*)(X + base), b = *(const float4*)(X + base + 4);
    float4 g0 = *(const float4*)(p.g_final + k), g1 = *(const float4*)(p.g_final + k + 4);
    *(float4*)(X + base) = make_float4(a.x * rs * g0.x, a.y * rs * g0.y, a.z * rs * g0.z, a.w * rs * g0.w);
    *(float4*)(X + base + 4) = make_float4(b.x * rs * g1.x, b.y * rs * g1.y, b.z * rs * g1.z, b.w * rs * g1.w);
  }
}

#define XB_TMO      128
#define XB_XCNT(j)  (256  + 64 * (j))
#define XB_XSUB(j)  (1280 + 64 * (j))
#define XB_XGEN(j)  (2304 + 64 * (j))
#define XB_TOP      3328
#define XB_TOPGEN   3392
#define XCD_BAR_WORDS 3456
#define XB_SPIN_CAP (1u << 22)
#define LAS __attribute__((address_space(3)))
__device__ __forceinline__ unsigned xb_ld(unsigned* p)              { return __hip_atomic_load(p, __ATOMIC_RELAXED, __HIP_MEMORY_SCOPE_AGENT); }
__device__ __forceinline__ unsigned xb_add(unsigned* p, unsigned v) { return __hip_atomic_fetch_add(p, v, __ATOMIC_RELAXED, __HIP_MEMORY_SCOPE_AGENT); }
__device__ __forceinline__ unsigned xb_xcc_id() { return (unsigned)__builtin_amdgcn_s_getreg((3 << 11) | 20) & 0xFu; }
#define XB_SPIN(cond, bar) do { unsigned _sp = 0; while (cond) { __builtin_amdgcn_s_sleep(1); \
    if ((++_sp & 255u) == 0u) { if (xb_ld(&(bar)[XB_TMO])) break; if (_sp > XB_SPIN_CAP) { atomicAdd(&(bar)[XB_TMO], 1u); break; } } } } while (0)
struct XcdBarrier { unsigned* bar; unsigned x; volatile LAS unsigned* st; };
__device__ __forceinline__ XcdBarrier xcd_barrier_post(unsigned* bar, volatile LAS unsigned* st) {
    XcdBarrier b; b.bar = bar; b.x = xb_xcc_id(); b.st = st;
    if (threadIdx.x == 0) (void)xb_add(&bar[XB_XCNT(b.x)], 1u);
    return b;
}
__device__ __forceinline__ void xcd_barrier_complete(unsigned* bar, unsigned x, unsigned& nloc, unsigned& nx) {
    const unsigned G = gridDim.x * gridDim.y * gridDim.z;
    unsigned sum, cnt, mine, sp = 0u;
    for (;;) {
        sum = 0u; cnt = 0u; mine = 0u;
#pragma unroll
        for (unsigned j = 0; j < 16; ++j) { const unsigned c = xb_ld(&bar[XB_XCNT(j)]); sum += c; cnt += (c > 0u) ? 1u : 0u; mine = (j == x) ? c : mine; }
        if (sum == G) break;
        __builtin_amdgcn_s_sleep(1);
        if ((++sp & 255u) == 0u) { if (xb_ld(&bar[XB_TMO])) break; if (sp > XB_SPIN_CAP) { atomicAdd(&bar[XB_TMO], 1u); break; } }
    }
    nloc = mine > 0u ? mine : 1u; nx = cnt > 0u ? cnt : 1u;
}
__device__ __forceinline__ void xcd_barrier(const XcdBarrier& b) {
    asm volatile("s_waitcnt vmcnt(0)" ::: "memory");
    __syncthreads();
    if (threadIdx.x == 0) {
        unsigned* bar = b.bar;
        __builtin_amdgcn_s_waitcnt(0);
        unsigned nloc = b.st[0], nx = b.st[1];
        if (nloc == 0u) { xcd_barrier_complete(bar, b.x, nloc, nx); b.st[0] = nloc; b.st[1] = nx; }
        const unsigned old = xb_add(&bar[XB_XSUB(b.x)], 1u);
        const unsigned gen = old / nloc;
        if (old + 1u == (gen + 1u) * nloc) {
            __builtin_amdgcn_fence(__ATOMIC_RELEASE, "agent");
            asm volatile("s_waitcnt vmcnt(0)" ::: "memory");
            const unsigned og = xb_add(&bar[XB_TOP], 1u);
            const unsigned tg = og / nx;
            if (og + 1u == (tg + 1u) * nx) xb_add(&bar[XB_TOPGEN], 1u);
            else XB_SPIN(xb_ld(&bar[XB_TOPGEN]) == tg, bar);
            __builtin_amdgcn_fence(__ATOMIC_ACQUIRE, "agent");
            xb_add(&bar[XB_XGEN(b.x)], 1u);
            asm volatile("s_waitcnt vmcnt(0)" ::: "memory");
        } else {
            XB_SPIN(xb_ld(&bar[XB_XGEN(b.x)]) == gen, bar);
            __builtin_amdgcn_fence(__ATOMIC_ACQUIRE, "agent");
            asm volatile("s_waitcnt vmcnt(0)" ::: "memory");
        }
    }
    __syncthreads();
}

__global__ void __launch_bounds__(256) mega_kernel(Params p) {
  __shared__ __attribute__((aligned(16))) char smem[SMEM_BYTES];
  cg::grid_group grid = cg::this_grid();
  __shared__ uint4 xb_words;
  if (threadIdx.x == 0) xb_words = make_uint4(0u, 0u, 0u, 0u);
  __syncthreads();
  XcdBarrier xb = xcd_barrier_post((unsigned*)(p.ws + OFF_BAR), (volatile LAS unsigned*)&xb_words);
  phase0(p, smem);
  if (p.ws == nullptr) grid.sync();
  xcd_barrier(xb);
#if PROBE == 9
  for (int i = 0; i < 20; i++) xcd_barrier(xb);
#endif
#if PROBE == 10
  phase0(p, smem);
  xcd_barrier(xb);
#endif
  phase1(p, smem);
  xcd_barrier(xb);
#if PROBE == 1
  phase1(p, smem);
  xcd_barrier(xb);
#endif
  phase2(p, smem);
  xcd_barrier(xb);
#if PROBE == 2
  phase2(p, smem);
  xcd_barrier(xb);
#endif
#if PROBE == 21
  phase2(p, smem, 0, 1024);
  xcd_barrier(xb);
#endif
#if PROBE == 22
  phase2(p, smem, 1024, 2048);
  xcd_barrier(xb);
#endif
#if PROBE == 23
  phase2(p, smem, 2048, 3072);
  xcd_barrier(xb);
#endif
#if PROBE == 6
  phase3(p, smem, false);
  xcd_barrier(xb);
#endif
  phase3(p, smem);
  xcd_barrier(xb);
  phase4a(p, smem);
  xcd_barrier(xb);
  phase4a_fixup(p);
  xcd_barrier(xb);
#if PROBE == 3
  phase4a(p, smem);
  xcd_barrier(xb);
#endif
  phase4b(p, smem);
  xcd_barrier(xb);
  phase4c(p, smem);
  xcd_barrier(xb);
#if PROBE == 4
  phase4c(p, smem);
  xcd_barrier(xb);
#endif
#if PROBE == 5
  phase5(p, smem, false);
  xcd_barrier(xb);
#endif
  phase5(p, smem);
  xcd_barrier(xb);
  phase6(p, smem);
  xcd_barrier(xb);
  phase7(p);
}

extern "C" void kernel_launch(void* const* d_in, const int* in_sizes, int n_in, void* d_out, int out_size,
                              void* d_ws, size_t ws_size, hipStream_t stream) {
  static int grid_blocks = 0;
  if (!grid_blocks) {
    int dev = 0, cus = 0, per_cu = 0;
    hipGetDevice(&dev);
    hipDeviceGetAttribute(&cus, hipDeviceAttributeMultiprocessorCount, dev);
    hipOccupancyMaxActiveBlocksPerMultiprocessor(&per_cu, mega_kernel, 256, 0);
    if (per_cu > 2) per_cu = 2;
    if (per_cu < 1) per_cu = 1;
    grid_blocks = cus * per_cu;
  }
  if (ws_size < WS_TOTAL) { fprintf(stderr, "workspace too small: %zu < %zu\n", ws_size, (size_t)WS_TOTAL); return; }
  Params p{};
  const float** pf = (const float**)&p;
  for (int i = 0; i < 27; i++) pf[i] = (const float*)d_in[i];
  p.out = (float*)d_out;
  p.ws = (char*)d_ws;
  hipMemsetAsync((char*)d_ws + OFF_BAR, 0, 16384, stream);
  void* args[] = {&p};
  hipError_t e = hipLaunchCooperativeKernel((void*)mega_kernel, dim3(grid_blocks), dim3(256), args, 0, stream);
  if (e != hipSuccess) fprintf(stderr, "cooperative launch failed: %s (grid %d)\n", hipGetErrorString(e), grid_blocks);
}
```
